# Optimizing an MI355X kernel written in HIP

```python
import jax, jax.numpy as jnp
from jax import lax
import numpy as np

D_MODEL = 1024
BATCH = 4
SEQ = 8192
DEPTH = 2

N_AB_LAYERS = (DEPTH + 1) // 2
N_C_LAYERS = DEPTH // 2

DN_HEADS = 4
DN_HEAD_DIM = 128
DN_KEY = DN_HEADS * DN_HEAD_DIM
DN_VAL = DN_HEADS * DN_HEAD_DIM
DN_CONV = 4
DN_CHUNK = 64
SG_GROUPS = 4
SG_GROUP_DIM = 128
SG_WIDTH = SG_GROUPS * SG_GROUP_DIM
SG_CHUNK = 128
POOL_WINDOWS = (2, 4, 8, 16)
POOL_GROUP_DIM = D_MODEL // len(POOL_WINDOWS)
D_FF = 2816
NORM_EPS = 1e-6

MIX_WIDTH = DN_VAL + SG_WIDTH
PROJ_SIZES = (DN_KEY, DN_KEY, DN_VAL, DN_VAL, DN_HEADS, DN_HEADS, SG_WIDTH, SG_WIDTH)
IN_PROJ = int(sum(PROJ_SIZES))
SPLIT_POINTS = tuple(int(s) for s in np.cumsum(PROJ_SIZES)[:-1])
QKV_WIDTH = 2 * DN_KEY + DN_VAL

kernel_name = "hybrid_deltanet_sgmlp_pool_macaron"


def _rmsnorm(x, w):
    xf = x.astype(jnp.float32)
    y = xf * lax.rsqrt(jnp.mean(xf * xf, axis=-1, keepdims=True) + NORM_EPS)
    return (y * w.astype(jnp.float32)).astype(x.dtype)


def _l2norm(x):
    return x * lax.rsqrt(jnp.sum(x * x, axis=-1, keepdims=True) + NORM_EPS)


def _swiglu(h, w_in, w_out):
    gate, up = jnp.split(h @ w_in, 2, axis=-1)
    return (jax.nn.silu(gate) * up) @ w_out


def _causal_dwconv(x, w):
    c = x.shape[-1]
    return lax.conv_general_dilated(
        x, w[:, None, :].astype(x.dtype), window_strides=(1,), padding=[(w.shape[0] - 1, 0)],
        dimension_numbers=("NWC", "WIO", "NWC"), feature_group_count=c)


def _gated_delta_rule(q, k, v, g, beta):
    bsz, t, h, dk = q.shape
    dv = v.shape[-1]
    n, c = t // DN_CHUNK, DN_CHUNK

    def chunk(a):
        return jnp.moveaxis(a.reshape((bsz, n, c, h) + a.shape[3:]), 3, 1)

    q = chunk(_l2norm(q) * dk ** -0.5)
    k = chunk(_l2norm(k))
    v = chunk(v)
    beta = chunk(beta)
    g = jnp.cumsum(chunk(g), axis=-1)
    causal = jnp.tril(jnp.ones((c, c), dtype=bool))
    strict = jnp.tril(jnp.ones((c, c), dtype=bool), k=-1)
    diff = g[..., :, None] - g[..., None, :]
    decay = jnp.where(causal, jnp.exp(jnp.where(causal, diff, 0.0)), 0.0)
    k_beta = k * beta[..., None]
    lower = jnp.where(strict, jnp.einsum('bhncd,bhnsd->bhncs', k_beta, k) * decay, 0.0)
    eye = jnp.eye(c, dtype=q.dtype)
    rhs = jnp.concatenate([v * beta[..., None], k_beta * jnp.exp(g)[..., None]], axis=-1)
    sol = lax.linalg.triangular_solve(eye + lower, rhs, left_side=True, lower=True, unit_diagonal=True)
    u, w = sol[..., :dv], sol[..., dv:]
    attn = jnp.einsum('bhncd,bhnsd->bhncs', q, k) * decay
    q_dec = q * jnp.exp(g)[..., None]
    g_last = g[..., -1]
    k_tail = k * jnp.exp(g_last[..., None] - g)[..., None]

    def step(state, inp):
        q_i, w_i, u_i, a_i, k_i, gl_i = inp
        v_new = u_i - jnp.einsum('bhck,bhkv->bhcv', w_i, state)
        o_i = jnp.einsum('bhck,bhkv->bhcv', q_i, state) + jnp.einsum('bhcs,bhsv->bhcv', a_i, v_new)
        state = state * jnp.exp(gl_i)[..., None, None] + jnp.einsum('bhck,bhcv->bhkv', k_i, v_new)
        return state, o_i

    xs = tuple(jnp.moveaxis(a, 2, 0) for a in (q_dec, w, u, attn, k_tail, g_last))
    state0 = jnp.zeros((bsz, h, dk, dv), q.dtype)
    _, o = lax.scan(step, state0, xs)
    return jnp.transpose(o, (1, 0, 3, 2, 4)).reshape(bsz, t, h, dv)


def _hybrid_ab_mixer(h, w_in, conv_w, a_log, dt_bias, dn_norm, sg_norm, sg_w, sg_b, w_out):
    bsz, t, _ = h.shape
    q, k, v, z, b, a, su, sv = jnp.split(h @ w_in, SPLIT_POINTS, axis=-1)
    qkv = jax.nn.silu(_causal_dwconv(jnp.concatenate([q, k, v], axis=-1), conv_w)).astype(jnp.float32)
    q, k, v = jnp.split(qkv, (DN_KEY, 2 * DN_KEY), axis=-1)
    q = q.reshape(bsz, t, DN_HEADS, DN_HEAD_DIM)
    k = k.reshape(bsz, t, DN_HEADS, DN_HEAD_DIM)
    v = v.reshape(bsz, t, DN_HEADS, DN_HEAD_DIM)
    beta = jax.nn.sigmoid(b.astype(jnp.float32))
    g = -jnp.exp(a_log.astype(jnp.float32)) * jax.nn.softplus(a.astype(jnp.float32) + dt_bias.astype(jnp.float32))
    o = _gated_delta_rule(q, k, v, g, beta)
    zf = z.astype(jnp.float32).reshape(bsz, t, DN_HEADS, DN_HEAD_DIM)
    o = _rmsnorm(o, dn_norm) * jax.nn.silu(zf)
    o_a = o.reshape(bsz, t, DN_VAL).astype(h.dtype)
    su = jax.nn.gelu(su, approximate=False).reshape(bsz, t, SG_GROUPS, SG_GROUP_DIM)
    sv = _rmsnorm(jax.nn.gelu(sv, approximate=False).reshape(bsz, t, SG_GROUPS, SG_GROUP_DIM), sg_norm)
    sv = sv.reshape(bsz, t // SG_CHUNK, SG_CHUNK, SG_GROUPS, SG_GROUP_DIM)
    tri = jnp.tril(jnp.ones((SG_CHUNK, SG_CHUNK), dtype=bool))
    w_s = jnp.where(tri, sg_w, 0.0).astype(sv.dtype)
    mixed = jnp.einsum('gts,bnsgc->bntgc', w_s, sv) + jnp.transpose(sg_b)[:, :, None].astype(sv.dtype)
    o_b = (su * mixed.reshape(bsz, t, SG_GROUPS, SG_GROUP_DIM)).reshape(bsz, t, SG_WIDTH)
    return jnp.concatenate([o_a, o_b], axis=-1) @ w_out


def _pool_mixer(h, pool_w, pool_scale):
    t = h.shape[1]
    hf = h.astype(jnp.float32)
    csum = jnp.cumsum(hf, axis=1)
    pos = jnp.arange(1, t + 1)
    outs = []
    for gi, win in enumerate(POOL_WINDOWS):
        sl = slice(gi * POOL_GROUP_DIM, (gi + 1) * POOL_GROUP_DIM)
        cs = csum[..., sl]
        lag = jnp.pad(cs[:, :-win], ((0, 0), (win, 0), (0, 0)))
        count = jnp.minimum(pos, win).astype(jnp.float32)[None, :, None]
        pooled = ((cs - lag) / count - hf[..., sl]).astype(h.dtype)
        outs.append(pooled @ pool_w[gi])
    return jnp.concatenate(outs, axis=-1) * pool_scale


def setup_inputs(seed: int = 0) -> dict:
    key = jax.random.key(seed)
    ks = jax.random.split(key, 24)
    f32 = jnp.float32
    nrm = lambda k, s, sc: jax.random.normal(k, s, f32) * sc
    gain = lambda k, s: 1.0 + 0.02 * jax.random.normal(k, s, f32)
    x = jax.random.normal(ks[0], (BATCH, SEQ, D_MODEL), f32)
    ffn_norm1 = gain(ks[1], (DEPTH, D_MODEL))
    ffn1_w_in = nrm(ks[2], (DEPTH, D_MODEL, 2 * D_FF), D_MODEL ** -0.5)
    ffn1_w_out = nrm(ks[3], (DEPTH, D_FF, D_MODEL), D_FF ** -0.5)
    mix_norm = gain(ks[4], (DEPTH, D_MODEL))
    ffn_norm2 = gain(ks[5], (DEPTH, D_MODEL))
    ffn2_w_in = nrm(ks[6], (DEPTH, D_MODEL, 2 * D_FF), D_MODEL ** -0.5)
    ffn2_w_out = nrm(ks[7], (DEPTH, D_FF, D_MODEL), D_FF ** -0.5)
    ab_w_in = nrm(ks[8], (N_AB_LAYERS, D_MODEL, IN_PROJ), D_MODEL ** -0.5)
    dn_conv_w = nrm(ks[9], (N_AB_LAYERS, DN_CONV, QKV_WIDTH), DN_CONV ** -0.5)
    dn_a_log = jnp.log(jax.random.uniform(ks[10], (N_AB_LAYERS, DN_HEADS), f32, 1.0, 16.0))
    dt = jnp.exp(jax.random.uniform(ks[11], (N_AB_LAYERS, DN_HEADS), f32, np.log(1e-3), np.log(1e-1)))
    dn_dt_bias = dt + jnp.log(-jnp.expm1(-dt))
    dn_out_norm = gain(ks[12], (N_AB_LAYERS, DN_HEAD_DIM))
    sg_norm = gain(ks[13], (N_AB_LAYERS, SG_GROUPS, SG_GROUP_DIM))
    sg_w = nrm(ks[14], (N_AB_LAYERS, SG_GROUPS, SG_CHUNK, SG_CHUNK), SG_CHUNK ** -0.5)
    sg_b = 1.0 + 0.1 * jax.random.normal(ks[15], (N_AB_LAYERS, SG_GROUPS, SG_CHUNK), f32)
    ab_w_out = nrm(ks[16], (N_AB_LAYERS, MIX_WIDTH, D_MODEL), MIX_WIDTH ** -0.5)
    pool_w = nrm(ks[17], (N_C_LAYERS, len(POOL_WINDOWS), POOL_GROUP_DIM, POOL_GROUP_DIM), POOL_GROUP_DIM ** -0.5)
    pool_scale = gain(ks[18], (N_C_LAYERS, D_MODEL))
    final_norm = gain(ks[19], (D_MODEL,))
    return {"x": x, "ffn_norm1": ffn_norm1, "ffn1_w_in": ffn1_w_in, "ffn1_w_out": ffn1_w_out,
            "mix_norm": mix_norm, "ffn_norm2": ffn_norm2, "ffn2_w_in": ffn2_w_in, "ffn2_w_out": ffn2_w_out,
            "ab_w_in": ab_w_in, "dn_conv_w": dn_conv_w, "dn_a_log": dn_a_log, "dn_dt_bias": dn_dt_bias,
            "dn_out_norm": dn_out_norm, "sg_norm": sg_norm, "sg_w": sg_w, "sg_b": sg_b, "ab_w_out": ab_w_out,
            "pool_w": pool_w, "pool_scale": pool_scale, "final_norm": final_norm}


def reference(x, ffn_norm1, ffn1_w_in, ffn1_w_out, mix_norm, ffn_norm2, ffn2_w_in, ffn2_w_out,
              ab_w_in, dn_conv_w, dn_a_log, dn_dt_bias, dn_out_norm, sg_norm, sg_w, sg_b, ab_w_out,
              pool_w, pool_scale, final_norm):
    for l in range(DEPTH):
        x = x + 0.5 * _swiglu(_rmsnorm(x, ffn_norm1[l]), ffn1_w_in[l], ffn1_w_out[l])
        h = _rmsnorm(x, mix_norm[l])
        i = l // 2
        if l % 2 == 0:
            x = x + _hybrid_ab_mixer(h, ab_w_in[i], dn_conv_w[i], dn_a_log[i], dn_dt_bias[i], dn_out_norm[i],
                                     sg_norm[i], sg_w[i], sg_b[i], ab_w_out[i])
        else:
            x = x + _pool_mixer(h, pool_w[i], pool_scale[i])
        x = x + 0.5 * _swiglu(_rmsnorm(x, ffn_norm2[l]), ffn2_w_in[l], ffn2_w_out[l])
    return _rmsnorm(x, final_norm)
```

```cpp
#include <hip/hip_runtime.h>
#include <hip/hip_cooperative_groups.h>
#include <cstdio>
namespace pg8 {
#define PG8_LAS __attribute__((address_space(3)))
typedef unsigned short bf16_t;
typedef short bf16x8 __attribute__((ext_vector_type(8)));
typedef float f32x4 __attribute__((ext_vector_type(4)));
typedef unsigned u32x4 __attribute__((ext_vector_type(4)));
constexpr int BM = 256, BK = 64, HALF = 128, HTB = HALF * BK * 2  , STAGE_BYTES = 8 * HTB, NXCD = 8, WGM = 8;

__host__ __device__ __forceinline__ int lds_byte(int r, int c) { const int st = (r >> 4) * 2 + (c >> 5), rr = r & 15, cc = c & 31, ob = rr * 64 + cc * 2; return st * 1024 + (ob ^ (((ob >> 9) & 1) << 5)); }
__host__ __device__ __forceinline__ void stage_rc(int b, int& R, int& C) { const int st = b / 1024, sb = b % 1024, swz = sb ^ (((sb >> 9) & 1) << 5); R = (st >> 1) * 16 + swz / 64; C = (st & 1) * 32 + (swz % 64) / 2; }
__host__ __device__ __forceinline__ int perm32(int rho) { const int n = rho >> 4, i = rho & 15; return 8 * (i >> 2) + 4 * n + (i & 3); }

struct Unit { int pm, pn; };
struct Gemm { const bf16_t* A; const bf16_t* Bt; int M, N, K; int lda; size_t a_pn_bytes; };

struct StaticOrder {
    int nM, nN, nwg, G, c;
    __host__ __device__ void init(int M, int N, int G_, int c_) { nM = M / BM; nN = N / BM; nwg = nM * nN; G = G_; c = c_; }
    __host__ __device__ bool next(int i, Unit& u) const {
        const long L = (long)i * G + c; if (L >= nwg) return false;
        int wgid = (int)L; { const int q = nwg / NXCD, r = nwg % NXCD, xcd = wgid % NXCD, off = wgid / NXCD; wgid = (xcd < r ? xcd * (q + 1) : r * (q + 1) + (xcd - r) * q) + off; }
        const int nig = WGM * nN, gid = wgid / nig, fm = gid * WGM, gsz = (nM - fm) < WGM ? (nM - fm) : WGM;
        u.pm = fm + ((wgid % nig) % gsz); u.pn = (wgid % nig) / gsz; return true;
    }
    __device__ __forceinline__ void a_ready(const Unit&) const {}
    __device__ __forceinline__ void done(const Unit&) const {}
};
__device__ __forceinline__ unsigned cvt_pk_bf16(float lo, float hi) { unsigned r; asm volatile("v_cvt_pk_bf16_f32 %0, %1, %2" : "=v"(r) : "v"(lo), "v"(hi)); return r; }
typedef float f32x2 __attribute__((ext_vector_type(2)));
__device__ __forceinline__ f32x2 gelu_pk(f32x2 v) {
    const f32x2 av = __builtin_elementwise_abs(v), d = av * 0.2316418882f + 1.0f;
    f32x2 t; t.x = __builtin_amdgcn_rcpf(d.x); t.y = __builtin_amdgcn_rcpf(d.y);
    f32x2 q = t * 0.5307027145f + (-0.7265760135f); q = q * t + 0.7107068705f; q = q * t + (-0.142248368f); q = q * t + 0.127414796f; q = q * t;
    const f32x2 s = (v * v) * (-0.72134752044f);
    f32x2 e; e.x = __builtin_amdgcn_exp2f(s.x); e.y = __builtin_amdgcn_exp2f(s.y);
    const f32x2 m = v * (q * e), r = v - m;
    f32x2 o; o.x = v.x < 0.f ? m.x : r.x; o.y = v.y < 0.f ? m.y : r.y; return o;
}

template <class Epi, class Sched>
__device__ __forceinline__ void gemm_phase(const int tid, PG8_LAS unsigned char* lds, const Gemm g, const Sched& S, const Epi& E) {
    const int wid = __builtin_amdgcn_readfirstlane(tid >> 6), lane = tid & 63, wr = wid >> 2, wc = wid & 3, fr = lane & 15, fq = lane >> 4;
    const int K = g.K, nt = K / BK;
    unsigned voffA[2], voffB[2];
#pragma unroll
    for (int i = 0; i < 2; ++i) { int R, C; stage_rc(tid * 16 + i * 8192, R, C); const int Rb = Epi::PERM ? ((R & ~31) + perm32(R & 31)) : R;
        voffA[i] = (unsigned)(R * g.lda + C) * 2u; voffB[i] = (unsigned)(Rb * K + C) * 2u; }
    const size_t kstep = (size_t)(BK * 2);
    const size_t hstepA = (size_t)HALF * g.lda * 2, hstepB = (size_t)HALF * K * 2;
    const size_t tstepA = 2 * hstepA, tstepB = 2 * hstepB;
    const unsigned ldsw = (unsigned)wid * 1024u;
    const int aoff = lds_byte(wr * 64 + fr, fq * 8), boff = lds_byte(wc * 32 + fr, fq * 8);
#define PG8_SA(b, h) (((b) * 2 + (h)) * HTB)
#define PG8_SB(b, h) ((4 + (b) * 2 + (h)) * HTB)
#define PG8_STAGE(bufoff, gbase, voff) do { _Pragma("unroll") for (int _i = 0; _i < 2; ++_i) \
        __builtin_amdgcn_global_load_lds((const unsigned*)((const char*)(gbase) + (voff)[_i]), (PG8_LAS unsigned*)(lds + (bufoff) + ldsw + _i * 8192), 16, 0, 0); } while (0)
#define PG8_LDA(dst, b, h) do { _Pragma("unroll") for (int m = 0; m < 4; ++m) _Pragma("unroll") for (int k = 0; k < 2; ++k) dst[m][k] = *(const PG8_LAS bf16x8*)(lds + PG8_SA(b, h) + aoff + m * 2048 + k * 1024); } while (0)
#define PG8_LDB(dst, b, h) do { _Pragma("unroll") for (int n = 0; n < 2; ++n) _Pragma("unroll") for (int k = 0; k < 2; ++k) dst[n][k] = *(const PG8_LAS bf16x8*)(lds + PG8_SB(b, h) + boff + n * 2048 + k * 1024); } while (0)
#define PG8_MMA(ai, bj, At, Bt) do { __builtin_amdgcn_s_setprio(1); _Pragma("unroll") for (int m = 0; m < 4; ++m) _Pragma("unroll") for (int n = 0; n < 2; ++n) _Pragma("unroll") for (int k = 0; k < 2; ++k) \
        acc[ai][bj][m][n] = __builtin_amdgcn_mfma_f32_16x16x32_bf16(Bt[n][k], At[m][k], acc[ai][bj][m][n], 0, 0, 0); __builtin_amdgcn_s_setprio(0); } while (0)
#define PG8_WAIT_V(n) asm volatile("s_waitcnt vmcnt(" #n ")" ::: "memory")
#define PG8_WAIT_L(n) asm volatile("s_waitcnt lgkmcnt(" #n ")" ::: "memory")
#define PG8_BAR __builtin_amdgcn_s_barrier()
#define PG8_SCHED __builtin_amdgcn_sched_barrier(0)
    Unit cur, nxt; int ui = 0;
    if (!S.next(0, cur)) return;
    f32x4 acc[2][2][4][2];
#pragma unroll
    for (int a = 0; a < 2; ++a)
#pragma unroll
        for (int b = 0; b < 2; ++b)
#pragma unroll
            for (int m = 0; m < 4; ++m)
#pragma unroll
                for (int n = 0; n < 2; ++n) acc[a][b][m][n] = (f32x4){0.f, 0.f, 0.f, 0.f};
    bf16x8 At[4][2], B0[2][2], B1[2][2];
    const char* cA = (const char*)g.A + (size_t)cur.pm * tstepA + (size_t)cur.pn * g.a_pn_bytes; const char* cB = (const char*)g.Bt + (size_t)cur.pn * tstepB;
    S.a_ready(cur);
    PG8_STAGE(PG8_SB(0, 0), cB, voffB); PG8_STAGE(PG8_SA(0, 0), cA, voffA); PG8_STAGE(PG8_SB(0, 1), cB + hstepB, voffB); PG8_STAGE(PG8_SA(0, 1), cA + hstepA, voffA);
    if (wr == 1) PG8_BAR;
    PG8_WAIT_V(4); PG8_BAR;
    PG8_STAGE(PG8_SB(1, 0), cB + kstep, voffB); PG8_STAGE(PG8_SA(1, 0), cA + kstep, voffA); PG8_STAGE(PG8_SB(1, 1), cB + hstepB + kstep, voffB);
    PG8_WAIT_V(6); PG8_BAR;
    for (;;) {
        const bool has_next = S.next(ui + 1, nxt);
        const char* nA = has_next ? (const char*)g.A + (size_t)nxt.pm * tstepA + (size_t)nxt.pn * g.a_pn_bytes : cA; const char* nB = has_next ? (const char*)g.Bt + (size_t)nxt.pn * tstepB : cB;
        for (int t = 0; t < nt; t += 2) {
            const bool last = (t == nt - 2);
            const char* a1 = cA + (size_t)(t + 1) * kstep;
            const char* a2 = last ? nA : cA + (size_t)(t + 2) * kstep; const char* b2 = last ? nB : cB + (size_t)(t + 2) * kstep;
            const char* a3 = a2 + kstep; const char* b3 = b2 + kstep;
            if (last && has_next) S.a_ready(nxt);
            PG8_LDB(B0, 0, 0); PG8_SCHED; PG8_LDA(At, 0, 0); PG8_STAGE(PG8_SA(1, 1), a1 + hstepA, voffA);
            PG8_WAIT_L(8); PG8_BAR; PG8_WAIT_L(0); PG8_MMA(0, 0, At, B0); PG8_BAR; PG8_SCHED;
            PG8_LDB(B1, 0, 1); PG8_STAGE(PG8_SB(0, 0), b2, voffB);
            PG8_BAR; PG8_WAIT_L(0); PG8_MMA(0, 1, At, B1); PG8_BAR;
            PG8_LDA(At, 0, 1); PG8_STAGE(PG8_SA(0, 0), a2, voffA);
            PG8_BAR; PG8_WAIT_L(0); PG8_MMA(1, 0, At, B0); PG8_BAR; PG8_SCHED;
            PG8_STAGE(PG8_SB(0, 1), b2 + hstepB, voffB);
            PG8_WAIT_V(6); PG8_BAR; PG8_MMA(1, 1, At, B1); PG8_BAR;
            PG8_LDB(B0, 1, 0); PG8_SCHED; PG8_LDA(At, 1, 0); PG8_STAGE(PG8_SA(0, 1), a2 + hstepA, voffA);
            PG8_WAIT_L(8); PG8_BAR; PG8_WAIT_L(0); PG8_MMA(0, 0, At, B0); PG8_BAR; PG8_SCHED;
            PG8_LDB(B1, 1, 1); PG8_STAGE(PG8_SB(1, 0), b3, voffB);
            PG8_BAR; PG8_WAIT_L(0); PG8_MMA(0, 1, At, B1); PG8_BAR;
            PG8_LDA(At, 1, 1); PG8_STAGE(PG8_SA(1, 0), a3, voffA);
            PG8_BAR; PG8_WAIT_L(0); PG8_MMA(1, 0, At, B0); PG8_BAR; PG8_SCHED;
            PG8_STAGE(PG8_SB(1, 1), b3 + hstepB, voffB);
            PG8_WAIT_V(6); PG8_BAR; PG8_MMA(1, 1, At, B1); PG8_BAR;
        }
        if constexpr (!Epi::AFTER_DRAIN) { E(acc, cur, wr, wc, fr, fq); S.done(cur); }
        if (!has_next) break;
#pragma unroll
        for (int a = 0; a < 2; ++a)
#pragma unroll
            for (int b = 0; b < 2; ++b)
#pragma unroll
                for (int m = 0; m < 4; ++m)
#pragma unroll
                    for (int n = 0; n < 2; ++n) acc[a][b][m][n] = (f32x4){0.f, 0.f, 0.f, 0.f};
        cur = nxt; cA = nA; cB = nB; ++ui;
    }
    PG8_WAIT_V(0);
    if (wr == 0) PG8_BAR;
    PG8_BAR;
    if constexpr (Epi::AFTER_DRAIN) { E.fused(acc, cur, wr, wc, fr, fq, lds, wid, lane); S.done(cur); }
#undef PG8_SA
#undef PG8_SB
#undef PG8_STAGE
#undef PG8_LDA
#undef PG8_LDB
#undef PG8_MMA
#undef PG8_WAIT_V
#undef PG8_WAIT_L
#undef PG8_BAR
#undef PG8_SCHED
}
}


namespace cg = cooperative_groups;
using pg8::bf16_t; using pg8::bf16x8; using pg8::f32x4; using pg8::u32x4; using pg8::f32x2;
#define LAS __attribute__((address_space(3)))
typedef unsigned u32x2 __attribute__((ext_vector_type(2)));

constexpr int MTOK = 32768, DM = 1024, FF = 2816, NFF = 5632, SEQ = 8192, NPROJ = 3328;
constexpr int LDS_BYTES = 144 * 1024;
constexpr int NTHREADS = 512;

constexpr size_t SZ_WFFIN1 = (size_t)NFF * DM * 2, SZ_WFFOUT1 = (size_t)DM * FF * 2;
constexpr size_t OFF_WFFIN = 0;
constexpr size_t OFF_WFFOUT = OFF_WFFIN + 4 * SZ_WFFIN1;
constexpr size_t OFF_WABIN = OFF_WFFOUT + 4 * SZ_WFFOUT1;
constexpr size_t OFF_WABOUT = OFF_WABIN + (size_t)NPROJ * DM * 2;
constexpr size_t OFF_WPOOL = OFF_WABOUT + (size_t)DM * DM * 2;
constexpr size_t OFF_SGW = OFF_WPOOL + (size_t)4 * 256 * 256 * 2;
constexpr size_t OFF_XB = OFF_SGW + (size_t)4 * 128 * 128 * 2;
constexpr size_t SZ_SSQ1 = (size_t)MTOK * 16 * 4;
constexpr size_t OFF_SSQ = OFF_XB + (size_t)MTOK * DM * 2;
constexpr size_t OFF_EG = OFF_SSQ + 2 * SZ_SSQ1;
constexpr size_t OFF_TAB = OFF_EG + 8192;
constexpr size_t OFF_BIG = OFF_TAB + 256;
constexpr size_t OFF_HB = OFF_BIG;
constexpr size_t OFF_QKV = OFF_BIG;
constexpr size_t OFF_STT = OFF_BIG;
constexpr size_t OFF_VNT = OFF_BIG + (size_t)2048 * 16384 * 2;
constexpr size_t OFF_ZUV = OFF_BIG + (size_t)MTOK * 1536 * 2;
constexpr size_t OFF_BA = OFF_ZUV + (size_t)MTOK * 1536 * 2;
constexpr size_t OFF_PW = OFF_BA + (size_t)MTOK * 8 * 4;
constexpr size_t OFF_PUT = OFF_PW + (size_t)2048 * 8192 * 2;
constexpr size_t OFF_PKT = OFF_PUT + (size_t)2048 * 8192 * 2;
constexpr size_t OFF_PQD = OFF_PKT + (size_t)2048 * 8192 * 2;
constexpr size_t OFF_PATT = OFF_PQD + (size_t)2048 * 8192 * 2;
constexpr size_t OFF_PO = OFF_BIG;
constexpr size_t WS_END = OFF_PATT + (size_t)2048 * 4096 * 2;

struct Params { const float* in[20]; float* out; unsigned char* ws; };
struct Ctx { int tid, bid, G; unsigned char* ws; const float* const* in; };

__device__ __forceinline__ unsigned short f2bf(float f) { unsigned u = __float_as_uint(f); u += 0x7FFFu + ((u >> 16) & 1u); return (unsigned short)(u >> 16); }
__device__ __forceinline__ float bf2f(unsigned short b) { return __uint_as_float(((unsigned)b) << 16); }
__device__ __forceinline__ unsigned pk2(float lo, float hi) { return (unsigned)f2bf(lo) | ((unsigned)f2bf(hi) << 16); }
__device__ __forceinline__ float bflo(unsigned w) { return __uint_as_float(w << 16); }
__device__ __forceinline__ float bfhi(unsigned w) { return __uint_as_float(w & 0xffff0000u); }
__device__ __forceinline__ float silu_f(float x) { return x / (1.0f + __expf(-x)); }
__device__ __forceinline__ float rstd_of(const float* ssq, size_t row) {
    const f32x4* s = (const f32x4*)(ssq + row * 16);
    const f32x4 a = s[0], b = s[1], c = s[2], d = s[3];
    const float t = ((a[0] + a[1]) + (a[2] + a[3])) + ((b[0] + b[1]) + (b[2] + b[3])) + ((c[0] + c[1]) + (c[2] + c[3])) + ((d[0] + d[1]) + (d[2] + d[3]));
    return rsqrtf(t * (1.0f / 1024.0f) + 1e-6f);
}
__device__ __forceinline__ float rstd_coop(const float* ssq, size_t row, int fq) {
    const f32x4 a = *(const f32x4*)(ssq + row * 16 + fq * 4);
    float t = (a[0] + a[1]) + (a[2] + a[3]);
    t += __shfl_xor(t, 16); t += __shfl_xor(t, 32);
    return rsqrtf(t * (1.0f / 1024.0f) + 1e-6f);
}
__device__ __forceinline__ float sel4(const f32x4 v, int r) { return r == 0 ? v[0] : (r == 1 ? v[1] : (r == 2 ? v[2] : v[3])); }
#define MFMA16(a, b, c) __builtin_amdgcn_mfma_f32_16x16x32_bf16((a), (b), (c), 0, 0, 0)

struct EpiSwiglu {
    static constexpr bool PERM = true, AFTER_DRAIN = false;
    bf16_t* H; const float* ssq;
    __device__ __forceinline__ void operator()(const f32x4 (&acc)[2][2][4][2], const pg8::Unit& u, int wr, int wc, int fr, int fq) const {
        const int row0 = u.pm * 256 + wr * 64 + fr, col0 = u.pn * 128 + wc * 32 + 8 * fq;
#pragma unroll
        for (int ai = 0; ai < 2; ++ai)
#pragma unroll
            for (int m = 0; m < 4; ++m) {
                const size_t row = (size_t)(row0 + ai * 128 + m * 16);
                const float rs = rstd_coop(ssq, row, fq);
                float hv[8];
#pragma unroll
                for (int n = 0; n < 2; ++n)
#pragma unroll
                    for (int j = 0; j < 4; ++j) { const float g = acc[ai][0][m][n][j] * rs, up = acc[ai][1][m][n][j] * rs; hv[n * 4 + j] = silu_f(g) * up; }
                u32x4 w; w.x = pk2(hv[0], hv[1]); w.y = pk2(hv[2], hv[3]); w.z = pk2(hv[4], hv[5]); w.w = pk2(hv[6], hv[7]);
                *(u32x4*)(H + row * FF + col0) = w;
            }
    }
};
struct EpiResid {
    static constexpr bool PERM = false, AFTER_DRAIN = false;
    const float* Xin; float* Xout; bf16_t* XB; float* ssq_out; float alpha; const float* colscale;
    __device__ __forceinline__ void operator()(const f32x4 (&acc)[2][2][4][2], const pg8::Unit& u, int wr, int wc, int fr, int fq) const {
        const int row0 = u.pm * 256 + wr * 64 + fr, col0 = u.pn * 256 + wc * 32 + 4 * fq;
        f32x4 cs[2][2];
#pragma unroll
        for (int bj = 0; bj < 2; ++bj)
#pragma unroll
            for (int n = 0; n < 2; ++n) { cs[bj][n] = colscale ? *(const f32x4*)(colscale + col0 + bj * 128 + n * 16) : (f32x4){1.f, 1.f, 1.f, 1.f}; cs[bj][n] *= alpha; }
#pragma unroll
        for (int ai = 0; ai < 2; ++ai)
#pragma unroll
            for (int m = 0; m < 4; ++m) {
                const size_t row = (size_t)(row0 + ai * 128 + m * 16);
                float ss = 0.f;
#pragma unroll
                for (int bj = 0; bj < 2; ++bj)
#pragma unroll
                    for (int n = 0; n < 2; ++n) {
                        const size_t off = row * DM + col0 + bj * 128 + n * 16;
                        const f32x4 xi = *(const f32x4*)(Xin + off);
                        const f32x4 xo = xi + acc[ai][bj][m][n] * cs[bj][n];
                        *(f32x4*)(Xout + off) = xo;
                        u32x2 w; w.x = pk2(xo[0], xo[1]); w.y = pk2(xo[2], xo[3]);
                        *(u32x2*)(XB + off) = w;
                        ss += (xo[0] * xo[0] + xo[1] * xo[1]) + (xo[2] * xo[2] + xo[3] * xo[3]);
                    }
                ss += __shfl_xor(ss, 16); ss += __shfl_xor(ss, 32);
                if (fq == 0) ssq_out[row * 16 + u.pn * 4 + wc] = ss;
            }
    }
};
struct EpiProj {
    static constexpr bool PERM = true, AFTER_DRAIN = false;
    bf16_t* QKV; bf16_t* ZUV; float* BA; const float* ssq;
    __device__ __forceinline__ void operator()(const f32x4 (&acc)[2][2][4][2], const pg8::Unit& u, int wr, int wc, int fr, int fq) const {
        const int row0 = u.pm * 256 + wr * 64 + fr, colw = wc * 32 + 8 * fq;
        const int pn = u.pn;
#pragma unroll
        for (int ai = 0; ai < 2; ++ai)
#pragma unroll
            for (int m = 0; m < 4; ++m) {
                const size_t row = (size_t)(row0 + ai * 128 + m * 16);
                const float rs = rstd_coop(ssq, row, fq);
#pragma unroll
                for (int bj = 0; bj < 2; ++bj) {
                    f32x4 v0 = acc[ai][bj][m][0] * rs, v1 = acc[ai][bj][m][1] * rs;
                    const int c = pn * 256 + bj * 128 + colw;
                    if (pn < 6) {
                        u32x4 w; w.x = pk2(v0[0], v0[1]); w.y = pk2(v0[2], v0[3]); w.z = pk2(v1[0], v1[1]); w.w = pk2(v1[2], v1[3]);
                        *(u32x4*)(QKV + row * 1536 + c) = w;
                    } else if (pn < 12) {
                        if (pn < 8) {
#pragma unroll
                            for (int j = 0; j < 4; ++j) { v0[j] = silu_f(v0[j]); v1[j] = silu_f(v1[j]); }
                        } else {
                            const f32x2 a = pg8::gelu_pk((f32x2){v0[0], v0[1]}), b = pg8::gelu_pk((f32x2){v0[2], v0[3]}), cc = pg8::gelu_pk((f32x2){v1[0], v1[1]}), d = pg8::gelu_pk((f32x2){v1[2], v1[3]});
                            v0 = (f32x4){a.x, a.y, b.x, b.y}; v1 = (f32x4){cc.x, cc.y, d.x, d.y};
                        }
                        u32x4 w; w.x = pk2(v0[0], v0[1]); w.y = pk2(v0[2], v0[3]); w.z = pk2(v1[0], v1[1]); w.w = pk2(v1[2], v1[3]);
                        *(u32x4*)(ZUV + row * 1536 + (c - 1536)) = w;
                    } else {
                        if (bj == 0 && colw == 0) { *(f32x4*)(BA + row * 8) = v0; *(f32x4*)(BA + row * 8 + 4) = v1; }
                    }
                }
            }
    }
};

struct MapId { __device__ __forceinline__ int operator()(int n) const { return n; } };
struct MapFfn { __device__ __forceinline__ int operator()(int n) const { const int pn = n >> 8, r = n & 255; return r < 128 ? 128 * pn + r : FF + 128 * pn + (r - 128); } };
struct MapAb { __device__ __forceinline__ int operator()(int n) const { return n < 2048 ? n : (n < 3072 ? n + 8 : (n < 3080 ? n - 1024 : -1)); } };

template <class Map>
__device__ __forceinline__ void conv_tile(const Ctx& cx, LAS float* tile, const float* src, int ldsrc, const float* gain, bf16_t* dst, int K, int k0, int n0, Map map) {
    const int tid = cx.tid;
    { const int j = tid & 63, i0 = tid >> 6; const int col = map(n0 + j);
#pragma unroll
      for (int ii = 0; ii < 8; ++ii) { const int k = k0 + i0 + 8 * ii; float v = 0.f; if (col >= 0) { v = src[(size_t)k * ldsrc + col]; if (gain) v *= gain[k]; } tile[(i0 + 8 * ii) * 65 + j] = v; } }
    __syncthreads();
    { const int kk2 = (tid & 31) * 2, jj0 = tid >> 5;
#pragma unroll
      for (int q = 0; q < 4; ++q) { const int n = jj0 + 16 * q; const unsigned w = pk2(tile[kk2 * 65 + n], tile[(kk2 + 1) * 65 + n]); *(unsigned*)(dst + (size_t)(n0 + n) * K + k0 + kk2) = w; } }
    __syncthreads();
}

__device__ __forceinline__ void phase_prologue(const Ctx& cx, LAS unsigned char* lds, const Params& p) {
    LAS float* tile = (LAS float*)lds;
    unsigned char* ws = cx.ws;
    const int T_FFIN = 16 * 88, T_FFOUT = 44 * 16, T_ABIN = 16 * 52, T_ABOUT = 256, T_POOL = 16;
    const int E0 = 4 * T_FFIN, E1 = E0 + 4 * T_FFOUT, E2 = E1 + T_ABIN, E3 = E2 + T_ABOUT, E4 = E3 + 4 * T_POOL;
    for (int idx = cx.bid; idx < E4; idx += cx.G) {
        if (idx < E0) {
            const int w = idx / T_FFIN, t = idx % T_FFIN, l = w >> 1, which = w & 1;
            const float* src = (which ? p.in[6] : p.in[2]) + (size_t)l * DM * NFF;
            const float* gain = (which ? p.in[5] : p.in[1]) + l * DM;
            conv_tile(cx, tile, src, NFF, gain, (bf16_t*)(ws + OFF_WFFIN + (size_t)w * SZ_WFFIN1), DM, (t & 15) * 64, (t >> 4) * 64, MapFfn());
        } else if (idx < E1) {
            const int i2 = idx - E0, w = i2 / T_FFOUT, t = i2 % T_FFOUT, l = w >> 1, which = w & 1;
            const float* src = (which ? p.in[7] : p.in[3]) + (size_t)l * FF * DM;
            conv_tile(cx, tile, src, DM, nullptr, (bf16_t*)(ws + OFF_WFFOUT + (size_t)w * SZ_WFFOUT1), FF, (t % 44) * 64, (t / 44) * 64, MapId());
        } else if (idx < E2) {
            const int t = idx - E1;
            conv_tile(cx, tile, p.in[8], 3080, p.in[4], (bf16_t*)(ws + OFF_WABIN), DM, (t & 15) * 64, (t >> 4) * 64, MapAb());
        } else if (idx < E3) {
            const int t = idx - E2;
            conv_tile(cx, tile, p.in[16], DM, nullptr, (bf16_t*)(ws + OFF_WABOUT), DM, (t & 15) * 64, (t >> 4) * 64, MapId());
        } else {
            const int i2 = idx - E3, g = i2 >> 4, t = i2 & 15;
            conv_tile(cx, tile, p.in[17] + (size_t)g * 65536, 256, nullptr, (bf16_t*)(ws + OFF_WPOOL) + (size_t)g * 65536, 256, (t & 3) * 64, (t >> 2) * 64, MapId());
        }
    }
    if (cx.bid == 0 && cx.tid == 0) { const float** tab = (const float**)(ws + OFF_TAB);
#pragma unroll
        for (int i = 0; i < 20; ++i) tab[i] = p.in[i]; }
    { bf16_t* sgw = (bf16_t*)(ws + OFF_SGW); const float* src = p.in[14];
      for (int i = cx.bid * NTHREADS + cx.tid; i < 4 * 128 * 128; i += cx.G * NTHREADS) { const int s = i & 127, t = (i >> 7) & 127; sgw[i] = (s <= t) ? f2bf(src[i]) : (unsigned short)0; } }
    { const int wave = cx.tid >> 6, lane = cx.tid & 63; const float* x = p.in[0]; bf16_t* xb = (bf16_t*)(ws + OFF_XB); float* ssq = (float*)(ws + OFF_SSQ);
      for (int row = cx.bid * 8 + wave; row < MTOK; row += cx.G * 8) {
          const f32x4* src = (const f32x4*)(x + (size_t)row * DM); float ss = 0.f;
#pragma unroll
          for (int q = 0; q < 4; ++q) { const f32x4 v = src[lane + 64 * q]; ss += (v[0] * v[0] + v[1] * v[1]) + (v[2] * v[2] + v[3] * v[3]);
              u32x2 w; w.x = pk2(v[0], v[1]); w.y = pk2(v[2], v[3]); *(u32x2*)(xb + (size_t)row * DM + (lane + 64 * q) * 4) = w; }
          ss += __shfl_xor(ss, 1); ss += __shfl_xor(ss, 2);
          if ((lane & 3) == 0) ssq[(size_t)row * 16 + (lane >> 2)] = ss;
      } }
}

constexpr int PREP_HALF = 53248;
__device__ __forceinline__ void prep_unit(const Ctx& cx, LAS unsigned char* lds, const Params& p, int unit) {
    const int tid = cx.tid, half = tid >> 8, tt = tid & 255, lane = tid & 63, wl = (tid >> 6) & 3, fr = lane & 15, fq = lane >> 4;
    const int hp = unit & 1, n = (unit >> 1) & 127, b = unit >> 8;
    const int h = hp * 2 + half;
    const int uid = (b * 4 + h) * 128 + n;
    const size_t rowbase = (size_t)b * SEQ; const int t0 = n * 64;
    unsigned char* ws = cx.ws;
    LAS unsigned char* L = lds + half * PREP_HALF;
    LAS bf16_t* KB = (LAS bf16_t*)L; LAS bf16_t* QB = (LAS bf16_t*)(L + 17408); LAS float* LF = (LAS float*)(L + 34816);
    LAS float* GC = (LAS float*)(L + 52224); LAS float* BETA = GC + 64; LAS float* RK = GC + 128; LAS float* RQ = GC + 192;
    const bf16_t* QKV = (const bf16_t*)(ws + OFF_QKV);
    const float* BA = (const float*)(ws + OFF_BA);
    const float* convw = cx.in[9];
    if (tt < 64) {
        const size_t row = rowbase + t0 + tt;
        const float bv = BA[row * 8 + h], av = BA[row * 8 + 4 + h];
        const float beta = 1.0f / (1.0f + expf(-bv));
        const float A = expf(cx.in[10][h]); const float xx = av + cx.in[11][h];
        const float sp = fmaxf(xx, 0.f) + log1pf(expf(-fabsf(xx)));
        float g = -A * sp;
#pragma unroll
        for (int off = 1; off < 64; off <<= 1) { const float o = __shfl_up(g, off); if (lane >= off) g += o; }
        GC[tt] = g; BETA[tt] = beta;
        if (tt == 63) ((float*)(ws + OFF_EG))[uid] = expf(g);
    }
    LAS bf16_t* RAW = (LAS bf16_t*)L;
    for (int idx = tt; idx < 67 * 48; idx += 256) {
        const int r = idx / 48, seg = idx - r * 48, w3 = seg >> 4, c8 = (seg & 15) * 8;
        const int t = t0 - 3 + r;
        u32x4 x = {0u, 0u, 0u, 0u};
        if (t >= 0) x = *(const u32x4*)(QKV + (rowbase + t) * 1536 + w3 * 512 + h * 128 + c8);
        *(LAS u32x4*)(RAW + r * 384 + w3 * 128 + c8) = x;
    }
    __syncthreads();
    const int col = tt & 127, which = tt >> 7;
    float val[64], qv[32];
    {
        const int srccol = (which ? 512 : 1024) + h * 128 + col;
        const float c0 = convw[srccol], c1 = convw[1536 + srccol], c2 = convw[2 * 1536 + srccol], c3 = convw[3 * 1536 + srccol];
        const LAS bf16_t* src = RAW + 3 * 384 + (which ? 128 : 256) + col;
        float xm3 = bf2f(src[-3 * 384]), xm2 = bf2f(src[-2 * 384]), xm1 = bf2f(src[-1 * 384]);
#pragma unroll
        for (int i16 = 0; i16 < 4; ++i16) {
#pragma unroll
            for (int e = 0; e < 16; ++e) { const int i = i16 * 16 + e; const float xi = bf2f(src[i * 384]); const float y = c0 * xm3 + c1 * xm2 + c2 * xm1 + c3 * xi; val[i] = silu_f(y); xm3 = xm2; xm2 = xm1; xm1 = xi; }
            asm volatile("" ::: "memory");
        }
    }
    const int qt0 = which * 32;
    {
        const int srccol = h * 128 + col;
        const float c0 = convw[srccol], c1 = convw[1536 + srccol], c2 = convw[2 * 1536 + srccol], c3 = convw[3 * 1536 + srccol];
        const LAS bf16_t* src = RAW + (3 + qt0) * 384 + col;
        float xm3 = bf2f(src[-3 * 384]), xm2 = bf2f(src[-2 * 384]), xm1 = bf2f(src[-1 * 384]);
#pragma unroll
        for (int i16 = 0; i16 < 2; ++i16) {
#pragma unroll
            for (int e = 0; e < 16; ++e) { const int i = i16 * 16 + e; const float xi = bf2f(src[i * 384]); const float y = c0 * xm3 + c1 * xm2 + c2 * xm1 + c3 * xi; qv[i] = silu_f(y); xm3 = xm2; xm2 = xm1; xm1 = xi; }
            asm volatile("" ::: "memory");
        }
    }
    __syncthreads();
#pragma unroll
    for (int i = 0; i < 32; ++i) QB[(qt0 + i) * 136 + col] = f2bf(qv[i]);
    if (which) {
#pragma unroll
        for (int i = 0; i < 64; ++i) KB[i * 136 + col] = f2bf(val[i]);
    }
    __syncthreads();
    const int r0 = 16 * wl;
    f32x4 kk[4], qk[4];
    {
        bf16x8 ak[4], aq[4];
#pragma unroll
        for (int ks = 0; ks < 4; ++ks) { ak[ks] = *(const LAS bf16x8*)(KB + (r0 + fr) * 136 + ks * 32 + fq * 8); aq[ks] = *(const LAS bf16x8*)(QB + (r0 + fr) * 136 + ks * 32 + fq * 8); }
        f32x4 kd = {0.f, 0.f, 0.f, 0.f}, qd = {0.f, 0.f, 0.f, 0.f};
#pragma unroll
        for (int ks = 0; ks < 4; ++ks) { kd = MFMA16(ak[ks], ak[ks], kd); qd = MFMA16(aq[ks], aq[ks], qd); }
#pragma unroll
        for (int ct = 0; ct < 4; ++ct) {
            kk[ct] = (f32x4){0.f, 0.f, 0.f, 0.f}; qk[ct] = (f32x4){0.f, 0.f, 0.f, 0.f};
            if (ct <= wl) {
#pragma unroll
                for (int ks = 0; ks < 4; ++ks) { const bf16x8 bk = *(const LAS bf16x8*)(KB + (16 * ct + fr) * 136 + ks * 32 + fq * 8); kk[ct] = MFMA16(ak[ks], bk, kk[ct]); qk[ct] = MFMA16(aq[ks], bk, qk[ct]); }
            }
        }
        const float dk = sel4(kd, fr & 3), dq = sel4(qd, fr & 3);
        if ((fr >> 2) == fq) { RK[r0 + fr] = rsqrtf(dk + 1e-6f); RQ[r0 + fr] = rsqrtf(dq + 1e-6f) * 0.08838834764831845f; }
    }
    __syncthreads();
    LAS bf16_t* AT = KB;
    {
#pragma unroll
        for (int ct = 0; ct < 4; ++ct)
#pragma unroll
            for (int r = 0; r < 4; ++r) {
                const int c = r0 + fq * 4 + r, s = 16 * ct + fr;
                const float dec = __expf(fminf(GC[c] - GC[s], 0.f));
                const float lv = (c > s) ? kk[ct][r] * RK[c] * RK[s] * BETA[c] * dec : 0.f;
                LF[c * 68 + s] = lv;
                const float av = (c >= s) ? qk[ct][r] * RQ[c] * RK[s] * dec : 0.f;
                AT[c * 72 + s] = f2bf(av);
            }
    }
    __syncthreads();
    {
        const float glast = GC[63];
        if (which) {
            bf16_t* KT = (bf16_t*)(ws + OFF_PKT) + (size_t)uid * 8192 + col * 64;
#pragma unroll
            for (int i8 = 0; i8 < 8; ++i8) {
                float kt[8];
#pragma unroll
                for (int e = 0; e < 8; ++e) { const int i = i8 * 8 + e; const float gi = GC[i]; const float kn = val[i] * RK[i]; kt[e] = kn * __expf(glast - gi); val[i] = kn * BETA[i] * __expf(gi); }
                u32x4 w; w.x = pk2(kt[0], kt[1]); w.y = pk2(kt[2], kt[3]); w.z = pk2(kt[4], kt[5]); w.w = pk2(kt[6], kt[7]);
                *(u32x4*)(KT + i8 * 8) = w;
                asm volatile("" ::: "memory");
            }
        } else {
#pragma unroll
            for (int i8 = 0; i8 < 8; ++i8) {
#pragma unroll
                for (int e = 0; e < 8; ++e) val[i8 * 8 + e] *= BETA[i8 * 8 + e];
                asm volatile("" ::: "memory");
            }
        }
#pragma unroll
        for (int i8 = 0; i8 < 4; ++i8) {
#pragma unroll
            for (int e = 0; e < 8; ++e) { const int t = qt0 + i8 * 8 + e; QB[t * 136 + col] = f2bf(bf2f(QB[t * 136 + col]) * RQ[t] * __expf(GC[t])); }
            asm volatile("" ::: "memory");
        }
        bf16_t* ATT = (bf16_t*)(ws + OFF_PATT) + (size_t)uid * 4096;
#pragma unroll
        for (int k = 0; k < 2; ++k) { const int idx = tt + 256 * k, r = idx >> 3, c8 = (idx & 7) * 8; *(u32x4*)(ATT + r * 64 + c8) = *(const LAS u32x4*)(AT + r * 72 + c8); }
    }
#pragma unroll
    for (int i = 1; i < 64; ++i) {
        float a0 = 0.f, a1 = 0.f;
#pragma unroll
        for (int ch = 0; ch < (i + 3) / 4; ++ch) {
            const f32x4 l = *(const LAS f32x4*)(LF + i * 68 + ch * 4);
            a0 += l[0] * val[4 * ch] + l[1] * val[4 * ch + 1];
            a1 += l[2] * val[4 * ch + 2] + l[3] * val[4 * ch + 3];
        }
        val[i] -= (a0 + a1);
        asm volatile("" ::: "memory");
    }
    __syncthreads();
    if (which) {
#pragma unroll
        for (int i = 0; i < 64; ++i) KB[i * 136 + col] = f2bf(val[i]);
    } else {
        bf16_t* UT = (bf16_t*)(ws + OFF_PUT) + (size_t)uid * 8192 + col * 64;
#pragma unroll
        for (int i8 = 0; i8 < 8; ++i8) { u32x4 w; w.x = pk2(val[i8 * 8], val[i8 * 8 + 1]); w.y = pk2(val[i8 * 8 + 2], val[i8 * 8 + 3]); w.z = pk2(val[i8 * 8 + 4], val[i8 * 8 + 5]); w.w = pk2(val[i8 * 8 + 6], val[i8 * 8 + 7]); *(u32x4*)(UT + i8 * 8) = w; }
    }
    __syncthreads();
    {
        bf16_t* W = (bf16_t*)(ws + OFF_PW) + (size_t)uid * 8192;
        bf16_t* QD = (bf16_t*)(ws + OFF_PQD) + (size_t)uid * 8192;
#pragma unroll
        for (int k = 0; k < 4; ++k) { const int idx = tt + 256 * k, r = idx >> 4, c8 = (idx & 15) * 8;
            *(u32x4*)(W + r * 128 + c8) = *(const LAS u32x4*)(KB + r * 136 + c8);
            *(u32x4*)(QD + r * 128 + c8) = *(const LAS u32x4*)(QB + r * 136 + c8); }
    }
    __syncthreads();
}

__device__ __forceinline__ void sg_unit(const Ctx& cx, LAS unsigned char* lds, const Params& p, int unit) {
    const int tid = cx.tid, lane = tid & 63, w = tid >> 6, fr = lane & 15, fq = lane >> 4;
    const int g = unit & 3, nb = (unit >> 2) & 63, b = unit >> 8;
    unsigned char* ws = cx.ws;
    bf16_t* ZUV = (bf16_t*)(ws + OFF_ZUV);
    LAS bf16_t* SVT = (LAS bf16_t*)lds;
    const size_t row0 = (size_t)b * SEQ + nb * 128;
    {
        const int s = tid >> 2, qd = tid & 3;
        const u32x4* src = (const u32x4*)(ZUV + (row0 + s) * 1536 + 1024 + g * 128 + qd * 32);
        float v[32]; float ss = 0.f;
#pragma unroll
        for (int q = 0; q < 4; ++q) { const u32x4 x = src[q];
#pragma unroll
            for (int e = 0; e < 4; ++e) { v[q * 8 + 2 * e] = bflo(x[e]); v[q * 8 + 2 * e + 1] = bfhi(x[e]); } }
#pragma unroll
        for (int e = 0; e < 32; ++e) ss += v[e] * v[e];
        ss += __shfl_xor(ss, 1); ss += __shfl_xor(ss, 2);
        const float r = rsqrtf(ss * (1.0f / 128.0f) + 1e-6f);
        const float* gn = cx.in[13] + g * 128 + qd * 32;
#pragma unroll
        for (int e = 0; e < 32; ++e) SVT[(qd * 32 + e) * 136 + s] = f2bf(v[e] * r * gn[e]);
    }
    __syncthreads();
    f32x4 acc[8];
#pragma unroll
    for (int nt = 0; nt < 8; ++nt) acc[nt] = (f32x4){0.f, 0.f, 0.f, 0.f};
    {
        const bf16_t* sgw = (const bf16_t*)(ws + OFF_SGW) + (size_t)g * 16384 + (16 * w + fr) * 128 + fq * 8;
#pragma unroll
        for (int ks = 0; ks < 4; ++ks) {
            if (ks * 32 <= 16 * w + 15) {
                const bf16x8 bw = *(const bf16x8*)(sgw + ks * 32);
#pragma unroll
                for (int nt = 0; nt < 8; ++nt) { const bf16x8 a = *(const LAS bf16x8*)(SVT + (16 * nt + fr) * 136 + ks * 32 + fq * 8); acc[nt] = MFMA16(a, bw, acc[nt]); }
            }
        }
    }
    {
        const int t = 16 * w + fr;
        const float bias = cx.in[15][g * 128 + t];
        bf16_t* su = ZUV + (row0 + t) * 1536 + 512 + g * 128 + fq * 4;
#pragma unroll
        for (int nt = 0; nt < 8; ++nt) {
            const u32x2 x = *(const u32x2*)(su + 16 * nt);
            u32x2 o; o.x = pk2(bflo(x.x) * (acc[nt][0] + bias), bfhi(x.x) * (acc[nt][1] + bias)); o.y = pk2(bflo(x.y) * (acc[nt][2] + bias), bfhi(x.y) * (acc[nt][3] + bias));
            *(u32x2*)(su + 16 * nt) = o;
        }
    }
    __syncthreads();
}

__device__ __forceinline__ void phase_scan(const Ctx& cx, LAS unsigned char* lds, const Params& p) {
    if (cx.bid >= 128) return;
    const int tid = cx.tid, lane = tid & 63, w = __builtin_amdgcn_readfirstlane(tid >> 6), fr = lane & 15, fq = lane >> 4;
    const int bh = cx.bid >> 3, dv0 = (cx.bid & 7) * 16;
    unsigned char* ws = cx.ws;
    LAS bf16_t* ST = (LAS bf16_t*)lds;
    LAS bf16_t* VT = (LAS bf16_t*)(lds + 4352);
    const bf16_t* PW = (const bf16_t*)(ws + OFF_PW); const bf16_t* PUT = (const bf16_t*)(ws + OFF_PUT); const bf16_t* PKT = (const bf16_t*)(ws + OFF_PKT);
    const float* EG = (const float*)(ws + OFF_EG);
    bf16_t* STT = (bf16_t*)(ws + OFF_STT); bf16_t* VNT = (bf16_t*)(ws + OFF_VNT);
    for (int i = tid; i < 16 * 136 / 2; i += NTHREADS) ((LAS unsigned*)ST)[i] = 0u;
    f32x4 S = {0.f, 0.f, 0.f, 0.f};
    const int uid0 = bh * 128;
    const int mt = w & 3;
    bf16x8 aw[4], akt[2]; u32x2 uu; float eg;
    {
        const size_t ub = (size_t)uid0 * 8192;
#pragma unroll
        for (int ks = 0; ks < 4; ++ks) aw[ks] = *(const bf16x8*)(PW + ub + (16 * mt + fr) * 128 + ks * 32 + fq * 8);
        uu = *(const u32x2*)(PUT + ub + (dv0 + fr) * 64 + 16 * mt + fq * 4);
#pragma unroll
        for (int k2 = 0; k2 < 2; ++k2) akt[k2] = *(const bf16x8*)(PKT + ub + (16 * w + fr) * 64 + k2 * 32 + fq * 8);
        eg = EG[uid0];
    }
    __syncthreads();
#pragma unroll 1
    for (int n = 0; n < 128; ++n) {
        const int uid = uid0 + n;
        bf16x8 naw[4], nakt[2]; u32x2 nuu; float neg;
        {
            const int un = (n < 127) ? uid + 1 : uid;
            const size_t ub = (size_t)un * 8192;
#pragma unroll
            for (int ks = 0; ks < 4; ++ks) naw[ks] = *(const bf16x8*)(PW + ub + (16 * mt + fr) * 128 + ks * 32 + fq * 8);
            nuu = *(const u32x2*)(PUT + ub + (dv0 + fr) * 64 + 16 * mt + fq * 4);
#pragma unroll
            for (int k2 = 0; k2 < 2; ++k2) nakt[k2] = *(const bf16x8*)(PKT + ub + (16 * w + fr) * 64 + k2 * 32 + fq * 8);
            neg = EG[un];
        }
        if (w < 4) {
            f32x4 T = {0.f, 0.f, 0.f, 0.f};
#pragma unroll
            for (int ks = 0; ks < 4; ++ks) { const bf16x8 bs = *(const LAS bf16x8*)(ST + fr * 136 + ks * 32 + fq * 8); T = MFMA16(aw[ks], bs, T); }
            u32x2 o; o.x = pk2(bflo(uu.x) - T[0], bfhi(uu.x) - T[1]); o.y = pk2(bflo(uu.y) - T[2], bfhi(uu.y) - T[3]);
            *(LAS u32x2*)(VT + fr * 72 + 16 * mt + fq * 4) = o;
            *(u32x2*)(VNT + (size_t)uid * 8192 + (dv0 + fr) * 64 + 16 * mt + fq * 4) = o;
        }
        __syncthreads();
        {
            f32x4 acc = S * eg;
#pragma unroll
            for (int k2 = 0; k2 < 2; ++k2) { const bf16x8 bv = *(const LAS bf16x8*)(VT + fr * 72 + k2 * 32 + fq * 8); acc = MFMA16(akt[k2], bv, acc); }
            S = acc;
            u32x2 o; o.x = pk2(S[0], S[1]); o.y = pk2(S[2], S[3]);
            *(LAS u32x2*)(ST + fr * 136 + 16 * w + fq * 4) = o;
            if (n < 127) *(u32x2*)(STT + (size_t)(uid + 1) * 16384 + (dv0 + fr) * 128 + 16 * w + fq * 4) = o;
        }
        __syncthreads();
#pragma unroll
        for (int ks = 0; ks < 4; ++ks) aw[ks] = naw[ks];
        akt[0] = nakt[0]; akt[1] = nakt[1]; uu = nuu; eg = neg;
    }
}

__device__ __forceinline__ void out_unit(const Ctx& cx, const Params& p, int uid) {
    const int tid = cx.tid, lane = tid & 63, wl = (tid >> 6) & 3, fr = lane & 15, fq = lane >> 4;
    const int n = uid & 127, h = (uid >> 7) & 3, b = uid >> 9;
    unsigned char* ws = cx.ws;
    const bf16_t* QD = (const bf16_t*)(ws + OFF_PQD) + (size_t)uid * 8192 + (16 * wl + fr) * 128 + fq * 8;
    const bf16_t* ATT = (const bf16_t*)(ws + OFF_PATT) + (size_t)uid * 4096 + (16 * wl + fr) * 64 + fq * 8;
    const bf16_t* STT = (const bf16_t*)(ws + OFF_STT) + (size_t)uid * 16384 + fr * 128 + fq * 8;
    const bf16_t* VNT = (const bf16_t*)(ws + OFF_VNT) + (size_t)uid * 8192 + fr * 64 + fq * 8;
    bf16x8 qd[4], at[2];
#pragma unroll
    for (int ks = 0; ks < 4; ++ks) qd[ks] = *(const bf16x8*)(QD + ks * 32);
#pragma unroll
    for (int k2 = 0; k2 < 2; ++k2) at[k2] = *(const bf16x8*)(ATT + k2 * 32);
    f32x4 acc[8];
#pragma unroll
    for (int nt = 0; nt < 8; ++nt) {
        acc[nt] = (f32x4){0.f, 0.f, 0.f, 0.f};
        if (n > 0) {
#pragma unroll
            for (int ks = 0; ks < 4; ++ks) { const bf16x8 sf = *(const bf16x8*)(STT + nt * 16 * 128 + ks * 32); acc[nt] = MFMA16(sf, qd[ks], acc[nt]); }
        }
#pragma unroll
        for (int k2 = 0; k2 < 2; ++k2) { const bf16x8 vf = *(const bf16x8*)(VNT + nt * 16 * 64 + k2 * 32); acc[nt] = MFMA16(vf, at[k2], acc[nt]); }
    }
    float ss = 0.f;
#pragma unroll
    for (int nt = 0; nt < 8; ++nt) ss += (acc[nt][0] * acc[nt][0] + acc[nt][1] * acc[nt][1]) + (acc[nt][2] * acc[nt][2] + acc[nt][3] * acc[nt][3]);
    ss += __shfl_xor(ss, 16); ss += __shfl_xor(ss, 32);
    const float rr = rsqrtf(ss * (1.0f / 128.0f) + 1e-6f);
    const size_t row = (size_t)b * SEQ + n * 64 + 16 * wl + fr;
    bf16_t* z = (bf16_t*)(ws + OFF_ZUV) + row * 1536 + h * 128 + fq * 4;
    const float* gn = cx.in[12] + fq * 4;
#pragma unroll
    for (int nt = 0; nt < 8; ++nt) {
        const u32x2 x = *(const u32x2*)(z + 16 * nt);
        const f32x4 gv = *(const f32x4*)(gn + 16 * nt);
        u32x2 o; o.x = pk2(acc[nt][0] * rr * gv[0] * bflo(x.x), acc[nt][1] * rr * gv[1] * bfhi(x.x)); o.y = pk2(acc[nt][2] * rr * gv[2] * bflo(x.y), acc[nt][3] * rr * gv[3] * bfhi(x.y));
        *(u32x2*)(z + 16 * nt) = o;
    }
}

__device__ __forceinline__ void pool_unit(const Ctx& cx, LAS unsigned char* lds, const Params& p, const float* X, const float* ssq, int unit) {
    const int tid = cx.tid;
    const int tb = (unit & 127) * 64, b = unit >> 7;
    LAS float* RS = (LAS float*)lds;
    const size_t rowbase = (size_t)b * SEQ;
    if (tid < 79) { const int t = tb - 15 + tid; RS[tid] = (t >= 0) ? rstd_of(ssq, rowbase + t) : 0.f; }
    __syncthreads();
    const int c = tid * 2, g = tid >> 7, win = 2 << g;
    const float g0 = cx.in[4][DM + c], g1 = cx.in[4][DM + c + 1];
    const float* xc = X + rowbase * DM + c;
    float s0 = 0.f, s1 = 0.f;
    for (int t = tb - win + 1; t < tb; ++t) { if (t >= 0) { const float2 v = *(const float2*)(xc + (size_t)t * DM); const float r = RS[t - tb + 15]; s0 += v.x * r; s1 += v.y * r; } }
    bf16_t* PO = (bf16_t*)(cx.ws + OFF_PO) + (size_t)g * MTOK * 256 + (c & 255);
#pragma unroll 4
    for (int t = tb; t < tb + 64; ++t) {
        const float2 v = *(const float2*)(xc + (size_t)t * DM); const float r = RS[t - tb + 15];
        const float h0 = v.x * r, h1 = v.y * r;
        s0 += h0; s1 += h1;
        const float inv = 1.0f / (float)min(t + 1, win);
        const float o0 = (s0 * inv - h0) * g0, o1 = (s1 * inv - h1) * g1;
        *(unsigned*)(PO + (rowbase + t) * 256) = pk2(o0, o1);
        const int tl = t - win + 1;
        if (tl >= 0) { const float2 vl = *(const float2*)(xc + (size_t)tl * DM); const float rl = RS[tl - tb + 15]; s0 -= vl.x * rl; s1 -= vl.y * rl; }
    }
    __syncthreads();
}

__device__ __forceinline__ void phase_final(const Ctx& cx, const Params& p, float* X) {
    const int wave = cx.tid >> 6, lane = cx.tid & 63;
    const f32x4* gw = (const f32x4*)cx.in[19];
    for (int row = cx.bid * 8 + wave; row < MTOK; row += cx.G * 8) {
        f32x4* xr = (f32x4*)(X + (size_t)row * DM); f32x4 v[4]; float ss = 0.f;
#pragma unroll
        for (int q = 0; q < 4; ++q) { v[q] = xr[lane + 64 * q]; ss += (v[q][0] * v[q][0] + v[q][1] * v[q][1]) + (v[q][2] * v[q][2] + v[q][3] * v[q][3]); }
#pragma unroll
        for (int o = 1; o < 64; o <<= 1) ss += __shfl_xor(ss, o);
        const float r = rsqrtf(ss * (1.0f / 1024.0f) + 1e-6f);
#pragma unroll
        for (int q = 0; q < 4; ++q) xr[lane + 64 * q] = v[q] * r * gw[lane + 64 * q];
    }
}

enum { K_PROLOGUE = 0, K_SWIGLU, K_RESID, K_PROJ, K_PREP, K_SCAN, K_OUT, K_POOL, K_FINAL };

__global__ void __launch_bounds__(NTHREADS, 2) fwd_megakernel(Params p) {
    extern __shared__ __attribute__((aligned(16))) unsigned char lds_raw[];
    LAS unsigned char* lds = (LAS unsigned char*)lds_raw;
    cg::grid_group grid = cg::this_grid();
    { Ctx cx; cx.tid = threadIdx.x; cx.bid = blockIdx.x; cx.G = gridDim.x; cx.ws = p.ws; cx.in = nullptr;
#ifndef NO_PRO
      phase_prologue(cx, lds, p);
#endif
      grid.sync(); }
#pragma unroll 1
    for (int step = 1; step < 17; ++step) {
        Ctx cx; cx.tid = threadIdx.x; cx.bid = blockIdx.x; cx.G = gridDim.x; cx.ws = p.ws;
        asm volatile("" : "+v"(cx.tid)); asm volatile("" : "+s"(cx.bid)); asm volatile("" : "+s"(cx.G)); asm volatile("" : "+s"(cx.ws));
        cx.in = (const float* const*)(cx.ws + OFF_TAB);
        unsigned char* ws = cx.ws; const int G = cx.G;
        float* X = p.out;
        bf16_t* XB = (bf16_t*)(ws + OFF_XB);
        float* SSQ0 = (float*)(ws + OFF_SSQ); float* SSQ1 = (float*)(ws + OFF_SSQ + SZ_SSQ1);
        int kind = K_PROLOGUE, widx = 0, sidx = 0;
        int rmode = 0;
        switch (step) {
            case 1: kind = K_SWIGLU; widx = 0; sidx = 0; break;
            case 2: kind = K_RESID; widx = 0; sidx = 0; rmode = 0; break;
            case 3: kind = K_PROJ; sidx = 1; break;
            case 4: kind = K_PREP; break;
            case 5: kind = K_SCAN; break;
            case 6: kind = K_OUT; break;
            case 7: kind = K_RESID; sidx = 1; rmode = 1; break;
            case 8: kind = K_SWIGLU; widx = 1; sidx = 0; break;
            case 9: kind = K_RESID; widx = 1; sidx = 0; rmode = 0; break;
            case 10: kind = K_SWIGLU; widx = 2; sidx = 1; break;
            case 11: kind = K_RESID; widx = 2; sidx = 1; rmode = 0; break;
            case 12: kind = K_POOL; sidx = 0; break;
            case 13: kind = K_RESID; sidx = 0; rmode = 2; break;
            case 14: kind = K_SWIGLU; widx = 3; sidx = 1; break;
            case 15: kind = K_RESID; widx = 3; sidx = 1; rmode = 0; break;
            default: kind = K_FINAL; break;
        }
        const float* ssq_in = sidx ? SSQ1 : SSQ0; float* ssq_out = sidx ? SSQ0 : SSQ1;
        if (kind == K_SWIGLU) {
            pg8::Gemm g{XB, (const bf16_t*)(ws + OFF_WFFIN + (size_t)widx * SZ_WFFIN1), MTOK, NFF, DM, DM, 0};
            pg8::StaticOrder S; S.init(MTOK, NFF, G, cx.bid);
            EpiSwiglu E{(bf16_t*)(ws + OFF_HB), ssq_in};
#ifndef NO_G1
            pg8::gemm_phase<EpiSwiglu, pg8::StaticOrder>(cx.tid, lds, g, S, E);
#endif
        } else if (kind == K_RESID) {
            pg8::Gemm g; EpiResid E;
            if (rmode == 0) {
                g = pg8::Gemm{(const bf16_t*)(ws + OFF_HB), (const bf16_t*)(ws + OFF_WFFOUT + (size_t)widx * SZ_WFFOUT1), MTOK, DM, FF, FF, 0};
                E = EpiResid{step == 2 ? cx.in[0] : (const float*)X, X, XB, ssq_out, 0.5f, nullptr};
            } else if (rmode == 1) {
                g = pg8::Gemm{(const bf16_t*)(ws + OFF_ZUV), (const bf16_t*)(ws + OFF_WABOUT), MTOK, DM, DM, 1536, 0};
                E = EpiResid{(const float*)X, X, XB, ssq_out, 1.0f, nullptr};
            } else {
                g = pg8::Gemm{(const bf16_t*)(ws + OFF_PO), (const bf16_t*)(ws + OFF_WPOOL), MTOK, DM, 256, 256, (size_t)MTOK * 256 * 2};
                E = EpiResid{(const float*)X, X, XB, ssq_out, 1.0f, cx.in[18]};
            }
            pg8::StaticOrder S; S.init(MTOK, DM, G, cx.bid);
#ifndef NO_G2
            pg8::gemm_phase<EpiResid, pg8::StaticOrder>(cx.tid, lds, g, S, E);
#endif
        } else if (kind == K_PROJ) {
            pg8::Gemm g{XB, (const bf16_t*)(ws + OFF_WABIN), MTOK, NPROJ, DM, DM, 0};
            pg8::StaticOrder S; S.init(MTOK, NPROJ, G, cx.bid);
            EpiProj E{(bf16_t*)(ws + OFF_QKV), (bf16_t*)(ws + OFF_ZUV), (float*)(ws + OFF_BA), ssq_in};
#ifndef NO_G3
            pg8::gemm_phase<EpiProj, pg8::StaticOrder>(cx.tid, lds, g, S, E);
#endif
        } else if (kind == K_PREP) {
#pragma unroll 1
#ifndef NO_PREP
            for (int u = cx.bid; u < 1024; u += G) prep_unit(cx, lds, p, u);
#else
            for (int u = cx.bid; u < 0; u += G) {}
#endif
#pragma unroll 1
#ifndef NO_SG
            for (int u = cx.bid; u < 1024; u += G) sg_unit(cx, lds, p, u);
#else
            for (int u = cx.bid; u < 0; u += G) {}
#endif
        } else if (kind == K_SCAN) {
#ifndef NO_SCAN
            phase_scan(cx, lds, p);
#endif
        } else if (kind == K_OUT) {
#pragma unroll 1
#ifndef NO_OUT
            for (int u = cx.bid; u < 1024; u += G) out_unit(cx, p, 2 * u + (cx.tid >> 8));
#else
            for (int u = cx.bid; u < 0; u += G) {}
#endif
        } else if (kind == K_POOL) {
#pragma unroll 1
#ifndef NO_POOL
            for (int u = cx.bid; u < 512; u += G) pool_unit(cx, lds, p, X, ssq_in, u);
#else
            for (int u = cx.bid; u < 0; u += G) {}
#endif
        } else {
#ifndef NO_FIN
            phase_final(cx, p, X);
#endif
        }
        if (step < 16) grid.sync();
    }
}

extern "C" void kernel_launch(void* const* d_in, const int* in_sizes, int n_in, void* d_out, int out_size, void* d_ws, size_t ws_size, hipStream_t stream) {
    static int grid_blocks = 0;
    if (grid_blocks == 0) {
        if (n_in != 20 || ws_size < WS_END) { fprintf(stderr, "kernel_launch: need 20 inputs and %zu bytes of workspace (got %d, %zu)\n", (size_t)WS_END, n_in, ws_size); grid_blocks = -1; return; }
        int dev = 0, cus = 0, per_cu = 0;
        (void)hipGetDevice(&dev);
        (void)hipDeviceGetAttribute(&cus, hipDeviceAttributeMultiprocessorCount, dev);
        if (hipFuncSetAttribute((const void*)fwd_megakernel, hipFuncAttributeMaxDynamicSharedMemorySize, LDS_BYTES) != hipSuccess) { fprintf(stderr, "kernel_launch: hipFuncSetAttribute failed\n"); grid_blocks = -1; return; }
        if (hipOccupancyMaxActiveBlocksPerMultiprocessor(&per_cu, (const void*)fwd_megakernel, NTHREADS, LDS_BYTES) != hipSuccess || per_cu < 1) per_cu = 1;
        (void)hipGetLastError();
        grid_blocks = cus * 1;
        if (grid_blocks < 128) { fprintf(stderr, "kernel_launch: needs >= 128 CUs\n"); grid_blocks = -1; return; }
    }
    if (grid_blocks < 0) return;
    Params p{};
    for (int i = 0; i < 20; ++i) p.in[i] = (const float*)d_in[i];
    p.out = (float*)d_out; p.ws = (unsigned char*)d_ws;
    void* args[] = {&p};
    hipError_t e = hipLaunchCooperativeKernel((const void*)fwd_megakernel, dim3(grid_blocks), dim3(NTHREADS), args, LDS_BYTES, stream);
    if (e != hipSuccess) fprintf(stderr, "cooperative launch failed: %s (grid %d)\n", hipGetErrorString(e), grid_blocks);
}
```

```cpp
#include <hip/hip_runtime.h>
#include <hip/hip_cooperative_groups.h>
#include <cstdio>
namespace pg8 {
#define PG8_LAS __attribute__((address_space(3)))
typedef unsigned short bf16_t;
typedef short bf16x8 __attribute__((ext_vector_type(8)));
typedef float f32x4 __attribute__((ext_vector_type(4)));
typedef unsigned u32x4 __attribute__((ext_vector_type(4)));
constexpr int BM = 256, BK = 64, HALF = 128, HTB = HALF * BK * 2  , STAGE_BYTES = 8 * HTB, NXCD = 8, WGM = 8;

__host__ __device__ __forceinline__ int lds_byte(int r, int c) { const int st = (r >> 4) * 2 + (c >> 5), rr = r & 15, cc = c & 31, ob = rr * 64 + cc * 2; return st * 1024 + (ob ^ (((ob >> 9) & 1) << 5)); }
__host__ __device__ __forceinline__ void stage_rc(int b, int& R, int& C) { const int st = b / 1024, sb = b % 1024, swz = sb ^ (((sb >> 9) & 1) << 5); R = (st >> 1) * 16 + swz / 64; C = (st & 1) * 32 + (swz % 64) / 2; }
__host__ __device__ __forceinline__ int perm32(int rho) { const int n = rho >> 4, i = rho & 15; return 8 * (i >> 2) + 4 * n + (i & 3); }

struct Unit { int pm, pn; };
struct Gemm { const bf16_t* A; const bf16_t* Bt; int M, N, K; int lda; size_t a_pn_bytes; };

struct StaticOrder {
    int nM, nN, nwg, G, c;
    __host__ __device__ void init(int M, int N, int G_, int c_) { nM = M / BM; nN = N / BM; nwg = nM * nN; G = G_; c = c_; }
    __host__ __device__ bool next(int i, Unit& u) const {
        const long L = (long)i * G + c; if (L >= nwg) return false;
        int wgid = (int)L; { const int q = nwg / NXCD, r = nwg % NXCD, xcd = wgid % NXCD, off = wgid / NXCD; wgid = (xcd < r ? xcd * (q + 1) : r * (q + 1) + (xcd - r) * q) + off; }
        const int nig = WGM * nN, gid = wgid / nig, fm = gid * WGM, gsz = (nM - fm) < WGM ? (nM - fm) : WGM;
        u.pm = fm + ((wgid % nig) % gsz); u.pn = (wgid % nig) / gsz; return true;
    }
    __device__ __forceinline__ void a_ready(const Unit&) const {}
    __device__ __forceinline__ void done(const Unit&) const {}
};
__device__ __forceinline__ unsigned cvt_pk_bf16(float lo, float hi) { unsigned r; asm volatile("v_cvt_pk_bf16_f32 %0, %1, %2" : "=v"(r) : "v"(lo), "v"(hi)); return r; }
typedef float f32x2 __attribute__((ext_vector_type(2)));
__device__ __forceinline__ f32x2 gelu_pk(f32x2 v) {
    const f32x2 av = __builtin_elementwise_abs(v), d = av * 0.2316418882f + 1.0f;
    f32x2 t; t.x = __builtin_amdgcn_rcpf(d.x); t.y = __builtin_amdgcn_rcpf(d.y);
    f32x2 q = t * 0.5307027145f + (-0.7265760135f); q = q * t + 0.7107068705f; q = q * t + (-0.142248368f); q = q * t + 0.127414796f; q = q * t;
    const f32x2 s = (v * v) * (-0.72134752044f);
    f32x2 e; e.x = __builtin_amdgcn_exp2f(s.x); e.y = __builtin_amdgcn_exp2f(s.y);
    const f32x2 m = v * (q * e), r = v - m;
    f32x2 o; o.x = v.x < 0.f ? m.x : r.x; o.y = v.y < 0.f ? m.y : r.y; return o;
}

template <class Epi, class Sched>
__device__ __forceinline__ void gemm_phase(const int tid, PG8_LAS unsigned char* lds, const Gemm g, const Sched& S, const Epi& E) {
    const int wid = __builtin_amdgcn_readfirstlane(tid >> 6), lane = tid & 63, wr = wid >> 2, wc = wid & 3, fr = lane & 15, fq = lane >> 4;
    const int K = g.K, nt = K / BK;
    unsigned voffA[2], voffB[2];
#pragma unroll
    for (int i = 0; i < 2; ++i) { int R, C; stage_rc(tid * 16 + i * 8192, R, C); const int Rb = Epi::PERM ? ((R & ~31) + perm32(R & 31)) : R;
        voffA[i] = (unsigned)(R * g.lda + C) * 2u; voffB[i] = (unsigned)(Rb * K + C) * 2u; }
    const size_t kstep = (size_t)(BK * 2);
    const size_t hstepA = (size_t)HALF * g.lda * 2, hstepB = (size_t)HALF * K * 2;
    const size_t tstepA = 2 * hstepA, tstepB = 2 * hstepB;
    const unsigned ldsw = (unsigned)wid * 1024u;
    const int aoff = lds_byte(wr * 64 + fr, fq * 8), boff = lds_byte(wc * 32 + fr, fq * 8);
#define PG8_SA(b, h) (((b) * 2 + (h)) * HTB)
#define PG8_SB(b, h) ((4 + (b) * 2 + (h)) * HTB)
#define PG8_STAGE(bufoff, gbase, voff) do { const char* _sb = (const char*)(gbase); asm volatile("" : "+s"(_sb));   \
        _Pragma("unroll") for (int _i = 0; _i < 2; ++_i) \
        __builtin_amdgcn_global_load_lds((const unsigned*)(_sb + (voff)[_i]), (PG8_LAS unsigned*)(lds + (bufoff) + ldsw + _i * 8192), 16, 0, 0); } while (0)
#define PG8_LDA(dst, b, h) do { _Pragma("unroll") for (int m = 0; m < 4; ++m) _Pragma("unroll") for (int k = 0; k < 2; ++k) dst[m][k] = *(const PG8_LAS bf16x8*)(lds + PG8_SA(b, h) + aoff + m * 2048 + k * 1024); } while (0)
#define PG8_LDB(dst, b, h) do { _Pragma("unroll") for (int n = 0; n < 2; ++n) _Pragma("unroll") for (int k = 0; k < 2; ++k) dst[n][k] = *(const PG8_LAS bf16x8*)(lds + PG8_SB(b, h) + boff + n * 2048 + k * 1024); } while (0)
#define PG8_MMA(ai, bj, At, Bt) do { __builtin_amdgcn_s_setprio(1); _Pragma("unroll") for (int m = 0; m < 4; ++m) _Pragma("unroll") for (int n = 0; n < 2; ++n) _Pragma("unroll") for (int k = 0; k < 2; ++k) \
        acc[ai][bj][m][n] = __builtin_amdgcn_mfma_f32_16x16x32_bf16(Bt[n][k], At[m][k], acc[ai][bj][m][n], 0, 0, 0); __builtin_amdgcn_s_setprio(0); } while (0)
#define PG8_WAIT_V(n) asm volatile("s_waitcnt vmcnt(" #n ")" ::: "memory")
#define PG8_WAIT_L(n) asm volatile("s_waitcnt lgkmcnt(" #n ")" ::: "memory")
#define PG8_BAR __builtin_amdgcn_s_barrier()
#define PG8_SCHED __builtin_amdgcn_sched_barrier(0)
    Unit cur, nxt; int ui = 0;
    if (!S.next(0, cur)) return;
    f32x4 acc[2][2][4][2];
#pragma unroll
    for (int a = 0; a < 2; ++a)
#pragma unroll
        for (int b = 0; b < 2; ++b)
#pragma unroll
            for (int m = 0; m < 4; ++m)
#pragma unroll
                for (int n = 0; n < 2; ++n) acc[a][b][m][n] = (f32x4){0.f, 0.f, 0.f, 0.f};
    bf16x8 At[4][2], B0[2][2], B1[2][2];
    const char* cA = (const char*)g.A + (size_t)cur.pm * tstepA + (size_t)cur.pn * g.a_pn_bytes; const char* cB = (const char*)g.Bt + (size_t)cur.pn * tstepB;
    S.a_ready(cur);
    PG8_STAGE(PG8_SB(0, 0), cB, voffB); PG8_STAGE(PG8_SA(0, 0), cA, voffA); PG8_STAGE(PG8_SB(0, 1), cB + hstepB, voffB); PG8_STAGE(PG8_SA(0, 1), cA + hstepA, voffA);
    if (wr == 1) PG8_BAR;
    PG8_WAIT_V(4); PG8_BAR;
    PG8_STAGE(PG8_SB(1, 0), cB + kstep, voffB); PG8_STAGE(PG8_SA(1, 0), cA + kstep, voffA); PG8_STAGE(PG8_SB(1, 1), cB + hstepB + kstep, voffB);
    PG8_WAIT_V(6); PG8_BAR;
    for (;;) {
        const bool has_next = S.next(ui + 1, nxt);
        const char* nA = has_next ? (const char*)g.A + (size_t)nxt.pm * tstepA + (size_t)nxt.pn * g.a_pn_bytes : cA; const char* nB = has_next ? (const char*)g.Bt + (size_t)nxt.pn * tstepB : cB;
        for (int t = 0; t < nt; t += 2) {
            const bool last = (t == nt - 2);
            const char* a1 = cA + (size_t)(t + 1) * kstep;
            const char* a2 = last ? nA : cA + (size_t)(t + 2) * kstep; const char* b2 = last ? nB : cB + (size_t)(t + 2) * kstep;
            const char* a3 = a2 + kstep; const char* b3 = b2 + kstep;
            if (last && has_next) S.a_ready(nxt);
            PG8_LDB(B0, 0, 0); PG8_SCHED; PG8_LDA(At, 0, 0); PG8_STAGE(PG8_SA(1, 1), a1 + hstepA, voffA);
            PG8_WAIT_L(8); PG8_BAR; PG8_WAIT_L(0); PG8_MMA(0, 0, At, B0); PG8_BAR; PG8_SCHED;
            PG8_LDB(B1, 0, 1); PG8_STAGE(PG8_SB(0, 0), b2, voffB);
            PG8_BAR; PG8_WAIT_L(0); PG8_MMA(0, 1, At, B1); PG8_BAR;
            PG8_LDA(At, 0, 1); PG8_STAGE(PG8_SA(0, 0), a2, voffA);
            PG8_BAR; PG8_WAIT_L(0); PG8_MMA(1, 0, At, B0); PG8_BAR; PG8_SCHED;
            PG8_STAGE(PG8_SB(0, 1), b2 + hstepB, voffB);
            PG8_WAIT_V(6); PG8_BAR; PG8_MMA(1, 1, At, B1); PG8_BAR;
            PG8_LDB(B0, 1, 0); PG8_SCHED; PG8_LDA(At, 1, 0); PG8_STAGE(PG8_SA(0, 1), a2 + hstepA, voffA);
            PG8_WAIT_L(8); PG8_BAR; PG8_WAIT_L(0); PG8_MMA(0, 0, At, B0); PG8_BAR; PG8_SCHED;
            PG8_LDB(B1, 1, 1); PG8_STAGE(PG8_SB(1, 0), b3, voffB);
            PG8_BAR; PG8_WAIT_L(0); PG8_MMA(0, 1, At, B1); PG8_BAR;
            PG8_LDA(At, 1, 1); PG8_STAGE(PG8_SA(1, 0), a3, voffA);
            PG8_BAR; PG8_WAIT_L(0); PG8_MMA(1, 0, At, B0); PG8_BAR; PG8_SCHED;
            PG8_STAGE(PG8_SB(1, 1), b3 + hstepB, voffB);
            PG8_WAIT_V(6); PG8_BAR; PG8_MMA(1, 1, At, B1); PG8_BAR;
        }
        if (wr == 0) PG8_BAR;
        if constexpr (!Epi::AFTER_DRAIN) { E(acc, cur, wr, wc, fr, fq); S.done(cur); }
        if (!has_next) break;
#pragma unroll
        for (int a = 0; a < 2; ++a)
#pragma unroll
            for (int b = 0; b < 2; ++b)
#pragma unroll
                for (int m = 0; m < 4; ++m)
#pragma unroll
                    for (int n = 0; n < 2; ++n) acc[a][b][m][n] = (f32x4){0.f, 0.f, 0.f, 0.f};
        cur = nxt; cA = nA; cB = nB; ++ui;
        if (wr == 1) PG8_BAR;
    }
    PG8_WAIT_V(0);
    PG8_BAR;
    if constexpr (Epi::AFTER_DRAIN) { E.fused(acc, cur, wr, wc, fr, fq, lds, wid, lane); S.done(cur); }
#undef PG8_SA
#undef PG8_SB
#undef PG8_STAGE
#undef PG8_LDA
#undef PG8_LDB
#undef PG8_MMA
#undef PG8_WAIT_V
#undef PG8_WAIT_L
#undef PG8_BAR
#undef PG8_SCHED
}
}


namespace cg = cooperative_groups;
using pg8::bf16_t; using pg8::bf16x8; using pg8::f32x4; using pg8::u32x4; using pg8::f32x2;
#define LAS __attribute__((address_space(3)))
#define GAS __attribute__((address_space(1)))
typedef unsigned u32x2 __attribute__((ext_vector_type(2)));

constexpr int MTOK = 32768, DM = 1024, FF = 2816, NFF = 5632, SEQ = 8192, NPROJ = 3328;
constexpr int LDS_BYTES = 144 * 1024;
constexpr int NTHREADS = 512;

constexpr size_t SZ_WFFIN1 = (size_t)NFF * DM * 2, SZ_WFFOUT1 = (size_t)DM * FF * 2;
constexpr size_t OFF_WFFIN = 0;
constexpr size_t OFF_WFFOUT = OFF_WFFIN + 4 * SZ_WFFIN1;
constexpr size_t OFF_WABIN = OFF_WFFOUT + 4 * SZ_WFFOUT1;
constexpr size_t OFF_WABOUT = OFF_WABIN + (size_t)NPROJ * DM * 2;
constexpr size_t OFF_WPOOL = OFF_WABOUT + (size_t)DM * DM * 2;
constexpr size_t OFF_SGW = OFF_WPOOL + (size_t)4 * 256 * 256 * 2;
constexpr size_t OFF_XB = OFF_SGW + (size_t)4 * 128 * 128 * 2;
constexpr size_t SZ_SSQ1 = (size_t)MTOK * 16 * 4;
constexpr size_t OFF_SSQ = OFF_XB + (size_t)MTOK * DM * 2;
constexpr size_t OFF_EG = OFF_SSQ + 2 * SZ_SSQ1;
constexpr size_t OFF_TAB = OFF_EG + 8192;
constexpr size_t OFF_SCL = OFF_TAB + 256;
constexpr size_t OFF_BAR = OFF_SCL + 8192;
constexpr size_t OFF_BIG = OFF_BAR + 16384;
constexpr size_t OFF_HB = OFF_BIG;
constexpr size_t OFF_QKV = OFF_BIG;
constexpr size_t OFF_STT = OFF_BIG;
constexpr size_t OFF_VNT = OFF_BIG + (size_t)2048 * 16384 * 2;
constexpr size_t OFF_ZUV = OFF_BIG + (size_t)MTOK * 1536 * 2;
constexpr size_t OFF_BA = OFF_ZUV + (size_t)MTOK * 1536 * 2;
constexpr size_t OFF_PW = OFF_BA + (size_t)MTOK * 8 * 4;
constexpr size_t OFF_PUT = OFF_PW + (size_t)2048 * 8192 * 2;
constexpr size_t OFF_PKT = OFF_PUT + (size_t)2048 * 8192 * 2;
constexpr size_t OFF_PQD = OFF_PKT + (size_t)2048 * 8192 * 2;
constexpr size_t OFF_PATT = OFF_PQD + (size_t)2048 * 8192 * 2;
constexpr size_t OFF_PO = OFF_BIG;
constexpr size_t WS_END = OFF_PATT + (size_t)2048 * 4096 * 2;

struct Params { const float* in[20]; float* out; unsigned char* ws; };
struct Ctx { int tid, bid, G; unsigned char* ws; const float* const* in; };

__device__ __forceinline__ float bf2f(unsigned short b) { return __uint_as_float(((unsigned)b) << 16); }
typedef __bf16 bf16x2v __attribute__((ext_vector_type(2)));
__device__ __forceinline__ unsigned pk2(float lo, float hi) { const f32x2 v = {lo, hi}; const bf16x2v b = __builtin_convertvector(v, bf16x2v); return __builtin_bit_cast(unsigned, b); }
__device__ __forceinline__ unsigned short f2bf(float f) { return (unsigned short)pk2(f, 0.f); }
#define LDS_BARRIER() do { asm volatile("s_waitcnt lgkmcnt(0)" ::: "memory"); __builtin_amdgcn_s_barrier(); asm volatile("" ::: "memory"); } while (0)
__device__ __forceinline__ float bflo(unsigned w) { return __uint_as_float(w << 16); }
__device__ __forceinline__ float bfhi(unsigned w) { return __uint_as_float(w & 0xffff0000u); }
__device__ __forceinline__ float silu_f(float x) { return x * __builtin_amdgcn_rcpf(1.0f + __builtin_amdgcn_exp2f(x * -1.4426950408889634f)); }
__device__ __forceinline__ float rstd_of(const float* ssq, size_t row) {
    const f32x4* s = (const f32x4*)(ssq + row * 16);
    const f32x4 a = s[0], b = s[1], c = s[2], d = s[3];
    const float t = ((a[0] + a[1]) + (a[2] + a[3])) + ((b[0] + b[1]) + (b[2] + b[3])) + ((c[0] + c[1]) + (c[2] + c[3])) + ((d[0] + d[1]) + (d[2] + d[3]));
    return rsqrtf(t * (1.0f / 1024.0f) + 1e-6f);
}
__device__ __forceinline__ float rstd_coop(const float* ssq, size_t row, int fq) {
    const f32x4 a = *(const f32x4*)(ssq + row * 16 + fq * 4);
    float t = (a[0] + a[1]) + (a[2] + a[3]);
    t += __shfl_xor(t, 16); t += __shfl_xor(t, 32);
    return rsqrtf(t * (1.0f / 1024.0f) + 1e-6f);
}
__device__ __forceinline__ float sel4(const f32x4 v, int r) { return r == 0 ? v[0] : (r == 1 ? v[1] : (r == 2 ? v[2] : v[3])); }
#define MFMA16(a, b, c) __builtin_amdgcn_mfma_f32_16x16x32_bf16((a), (b), (c), 0, 0, 0)


#define XB_READY    64
#define XB_MAGIC    0x5EEDBA55u
#define XB_TMO      128
#define XB_XCNT(j)  (256  + 64 * (j))
#define XB_XSUB(j)  (1280 + 64 * (j))
#define XB_XGEN(j)  (2304 + 64 * (j))
#define XB_TOP      3328
#define XB_TOPGEN   3392
#define XCD_BAR_WORDS 3456
#define XB_SPIN_CAP (1u << 18)
__device__ __forceinline__ unsigned xb_ld(unsigned* p)              { return __hip_atomic_load(p, __ATOMIC_RELAXED, __HIP_MEMORY_SCOPE_AGENT); }
__device__ __forceinline__ unsigned xb_add(unsigned* p, unsigned v) { return __hip_atomic_fetch_add(p, v, __ATOMIC_RELAXED, __HIP_MEMORY_SCOPE_AGENT); }
__device__ __forceinline__ unsigned xb_xcc_id() { return (unsigned)__builtin_amdgcn_s_getreg((3 << 11) | 20) & 0xFu; }
#define XB_SPIN(cond, bar) do { unsigned _sp = 0; while (cond) { __builtin_amdgcn_s_sleep(1); \
    if ((++_sp & 255u) == 0u) { if (xb_ld(&(bar)[XB_TMO])) break; if (_sp > XB_SPIN_CAP) { atomicAdd(&(bar)[XB_TMO], 1u); break; } } } } while (0)
struct XcdBarrier { unsigned* bar; unsigned x; volatile LAS unsigned* st; };
__device__ __forceinline__ XcdBarrier xcd_barrier_post(unsigned* bar, volatile LAS unsigned* st) {
    XcdBarrier b; b.bar = bar; b.x = xb_xcc_id(); b.st = st;
    if (threadIdx.x == 0) (void)xb_add(&bar[XB_XCNT(b.x)], 1u);
    return b;
}
__device__ __forceinline__ void xcd_barrier_complete(unsigned* bar, unsigned x, unsigned& nloc, unsigned& nx) {
    const unsigned G = gridDim.x * gridDim.y * gridDim.z;
    unsigned sum, cnt, mine, sp = 0u;
    for (;;) {
        sum = 0u; cnt = 0u; mine = 0u;
#pragma unroll
        for (unsigned j = 0; j < 16; ++j) { const unsigned c = xb_ld(&bar[XB_XCNT(j)]); sum += c; cnt += (c > 0u) ? 1u : 0u; mine = (j == x) ? c : mine; }
        if (sum == G) break;
        __builtin_amdgcn_s_sleep(1);
        if ((++sp & 255u) == 0u) { if (xb_ld(&bar[XB_TMO])) break; if (sp > XB_SPIN_CAP) { atomicAdd(&bar[XB_TMO], 1u); break; } }
    }
    nloc = mine > 0u ? mine : 1u; nx = cnt > 0u ? cnt : 1u;
}
__device__ __forceinline__ void xcd_barrier(const XcdBarrier& b) {
    asm volatile("s_waitcnt vmcnt(0)" ::: "memory");
    __syncthreads();
    if (threadIdx.x == 0) {
        unsigned* bar = b.bar;
        __builtin_amdgcn_s_waitcnt(0);
        unsigned nloc = b.st[0], nx = b.st[1];
        if (nloc == 0u) { xcd_barrier_complete(bar, b.x, nloc, nx); b.st[0] = nloc; b.st[1] = nx; }
        const unsigned old = xb_add(&bar[XB_XSUB(b.x)], 1u);
        const unsigned gen = old / nloc;
        if (old + 1u == (gen + 1u) * nloc) {
            __builtin_amdgcn_fence(__ATOMIC_RELEASE, "agent");
            asm volatile("s_waitcnt vmcnt(0)" ::: "memory");
            const unsigned og = xb_add(&bar[XB_TOP], 1u);
            const unsigned tg = og / nx;
            if (og + 1u == (tg + 1u) * nx) xb_add(&bar[XB_TOPGEN], 1u);
            else XB_SPIN(xb_ld(&bar[XB_TOPGEN]) == tg, bar);
            __builtin_amdgcn_fence(__ATOMIC_ACQUIRE, "agent");
            xb_add(&bar[XB_XGEN(b.x)], 1u);
            asm volatile("s_waitcnt vmcnt(0)" ::: "memory");
        } else {
            XB_SPIN(xb_ld(&bar[XB_XGEN(b.x)]) == gen, bar);
            __builtin_amdgcn_fence(__ATOMIC_ACQUIRE, "agent");
            asm volatile("s_waitcnt vmcnt(0)" ::: "memory");
        }
    }
    __syncthreads();
}

struct EpiSwiglu {
    static constexpr bool PERM = true, AFTER_DRAIN = false;
    bf16_t* H; const LAS float* RS; mutable int ui;
    __device__ __forceinline__ void operator()(const f32x4 (&acc)[2][2][4][2], const pg8::Unit& u, int wr, int wc, int fr, int fq) const {
        const int row0 = u.pm * 256 + wr * 64 + fr, col0 = u.pn * 128 + wc * 32 + 8 * fq;
        const LAS float* rsu = RS + ui * 256 + wr * 64 + fr; ++ui;
#pragma unroll
        for (int ai = 0; ai < 2; ++ai)
#pragma unroll
            for (int m = 0; m < 4; ++m) {
                const size_t row = (size_t)(row0 + ai * 128 + m * 16);
                const float rs = rsu[ai * 128 + m * 16];
                float hv[8];
#pragma unroll
                for (int n = 0; n < 2; ++n)
#pragma unroll
                    for (int j = 0; j < 4; ++j) { const float g = acc[ai][0][m][n][j] * rs, up = acc[ai][1][m][n][j] * rs; hv[n * 4 + j] = silu_f(g) * up; }
                u32x4 w; w.x = pk2(hv[0], hv[1]); w.y = pk2(hv[2], hv[3]); w.z = pk2(hv[4], hv[5]); w.w = pk2(hv[6], hv[7]);
                *(GAS u32x4*)(H + row * FF + col0) = w;
            }
    }
};
struct EpiResid {
    static constexpr bool PERM = true, AFTER_DRAIN = false;
    bf16_t* XB; float* ssq_out; const float* colscale;
    __device__ __forceinline__ void operator()(const f32x4 (&acc)[2][2][4][2], const pg8::Unit& u, int wr, int wc, int fr, int fq) const {
        const int row0 = u.pm * 256 + wr * 64 + fr, col0 = u.pn * 256 + wc * 32 + 8 * fq;
        bf16_t* xb = XB + (size_t)row0 * DM + col0;
        u32x4 xin[2][4][2];
#pragma unroll
        for (int ai = 0; ai < 2; ++ai)
#pragma unroll
            for (int m = 0; m < 4; ++m)
#pragma unroll
                for (int bj = 0; bj < 2; ++bj) xin[ai][m][bj] = *(const GAS u32x4*)(xb + (size_t)(ai * 128 + m * 16) * DM + bj * 128);
        f32x4 cs[2][2];
#pragma unroll
        for (int bj = 0; bj < 2; ++bj)
#pragma unroll
            for (int n = 0; n < 2; ++n) cs[bj][n] = *(const GAS f32x4*)(colscale + col0 + bj * 128 + 4 * n);
#pragma unroll
        for (int ai = 0; ai < 2; ++ai)
#pragma unroll
            for (int m = 0; m < 4; ++m) {
                float ss = 0.f;
#pragma unroll
                for (int bj = 0; bj < 2; ++bj) {
                    const u32x4 x = xin[ai][m][bj];
                    const f32x4 v0 = acc[ai][bj][m][0] * cs[bj][0], v1 = acc[ai][bj][m][1] * cs[bj][1];
                    const float o0 = bflo(x.x) + v0[0], o1 = bfhi(x.x) + v0[1], o2 = bflo(x.y) + v0[2], o3 = bfhi(x.y) + v0[3];
                    const float o4 = bflo(x.z) + v1[0], o5 = bfhi(x.z) + v1[1], o6 = bflo(x.w) + v1[2], o7 = bfhi(x.w) + v1[3];
                    u32x4 w; w.x = pk2(o0, o1); w.y = pk2(o2, o3); w.z = pk2(o4, o5); w.w = pk2(o6, o7);
                    *(GAS u32x4*)(xb + (size_t)(ai * 128 + m * 16) * DM + bj * 128) = w;
                    ss += ((o0 * o0 + o1 * o1) + (o2 * o2 + o3 * o3)) + ((o4 * o4 + o5 * o5) + (o6 * o6 + o7 * o7));
                }
                ss += __shfl_xor(ss, 16); ss += __shfl_xor(ss, 32);
                if (fq == 0) *(GAS float*)(ssq_out + (size_t)(row0 + ai * 128 + m * 16) * 16 + u.pn * 4 + wc) = ss;
            }
    }
};
struct EpiProj {
    static constexpr bool PERM = true, AFTER_DRAIN = false;
    bf16_t* QKV; bf16_t* ZUV; float* BA; const LAS float* RS; mutable int ui;
    __device__ __forceinline__ void operator()(const f32x4 (&acc)[2][2][4][2], const pg8::Unit& u, int wr, int wc, int fr, int fq) const {
        const int row0 = u.pm * 256 + wr * 64 + fr, colw = wc * 32 + 8 * fq;
        const LAS float* rsu = RS + ui * 256 + wr * 64 + fr; ++ui;
        const int pn = u.pn;
#pragma unroll
        for (int ai = 0; ai < 2; ++ai)
#pragma unroll
            for (int m = 0; m < 4; ++m) {
                const size_t row = (size_t)(row0 + ai * 128 + m * 16);
                const float rs = rsu[ai * 128 + m * 16];
#pragma unroll
                for (int bj = 0; bj < 2; ++bj) {
                    f32x4 v0 = acc[ai][bj][m][0] * rs, v1 = acc[ai][bj][m][1] * rs;
                    const int c = pn * 256 + bj * 128 + colw;
                    if (pn < 6) {
                        u32x4 w; w.x = pk2(v0[0], v0[1]); w.y = pk2(v0[2], v0[3]); w.z = pk2(v1[0], v1[1]); w.w = pk2(v1[2], v1[3]);
                        *(GAS u32x4*)(QKV + row * 1536 + c) = w;
                    } else if (pn < 12) {
                        if (pn < 8) {
#pragma unroll
                            for (int j = 0; j < 4; ++j) { v0[j] = silu_f(v0[j]); v1[j] = silu_f(v1[j]); }
                        } else {
                            const f32x2 a = pg8::gelu_pk((f32x2){v0[0], v0[1]}), b = pg8::gelu_pk((f32x2){v0[2], v0[3]}), cc = pg8::gelu_pk((f32x2){v1[0], v1[1]}), d = pg8::gelu_pk((f32x2){v1[2], v1[3]});
                            v0 = (f32x4){a.x, a.y, b.x, b.y}; v1 = (f32x4){cc.x, cc.y, d.x, d.y};
                        }
                        u32x4 w; w.x = pk2(v0[0], v0[1]); w.y = pk2(v0[2], v0[3]); w.z = pk2(v1[0], v1[1]); w.w = pk2(v1[2], v1[3]);
                        *(GAS u32x4*)(ZUV + row * 1536 + (c - 1536)) = w;
                    } else {
                        if (bj == 0 && colw == 0) { *(GAS f32x4*)(BA + row * 8) = v0; *(GAS f32x4*)(BA + row * 8 + 4) = v1; }
                    }
                }
            }
    }
};

struct MapId { __device__ __forceinline__ int operator()(int n) const { return n; } };
struct MapFfn { __device__ __forceinline__ int operator()(int n) const { const int pn = n >> 8, r = n & 255; return r < 128 ? 128 * pn + r : FF + 128 * pn + (r - 128); } };
struct MapAb { __device__ __forceinline__ int operator()(int n) const { return n < 2048 ? n : (n < 3072 ? n + 8 : (n < 3080 ? n - 1024 : -1)); } };

constexpr int CT_EARLY = 1472, CT_ALL = 4800;
struct TileDesc { const float* src; const float* gain; bf16_t* dst; int ldsrc, K, k0, n0, mapk; };
__device__ __forceinline__ int tile_map(int mapk, int n) { return mapk == 0 ? n : (mapk == 1 ? MapFfn()(n) : MapAb()(n)); }
template <bool EARLY>
__device__ __forceinline__ TileDesc tile_decode(const Ctx& cx, const Params& p, int idx) {
#define INP(i) (EARLY ? p.in[i] : cx.in[i])
    unsigned char* ws = cx.ws; TileDesc d;
    if (idx < 704 || (idx >= 1472 && idx < 3584)) {
        const int i2 = idx < 704 ? idx : idx - 1472, w = idx < 704 ? 0 : 1 + i2 / 704, t = i2 % 704, l = w >> 1, which = w & 1;
        d.src = (which ? INP(6) : INP(2)) + (size_t)l * DM * NFF; d.gain = (which ? INP(5) : INP(1)) + l * DM;
        d.dst = (bf16_t*)(ws + OFF_WFFIN + (size_t)w * SZ_WFFIN1); d.ldsrc = NFF; d.K = DM; d.k0 = (t & 15) * 64; d.n0 = (t >> 4) * 128; d.mapk = 1;
    } else if (idx < 1056 || (idx >= 3584 && idx < 4640)) {
        const int i2 = idx < 1056 ? idx - 704 : idx - 3584, w = idx < 1056 ? 0 : 1 + i2 / 352, t = i2 % 352, l = w >> 1, which = w & 1;
        d.src = (which ? INP(7) : INP(3)) + (size_t)l * FF * DM; d.gain = nullptr;
        d.dst = (bf16_t*)(ws + OFF_WFFOUT + (size_t)w * SZ_WFFOUT1); d.ldsrc = DM; d.K = FF; d.k0 = (t % 44) * 64; d.n0 = (t / 44) * 128; d.mapk = 0;
    } else if (idx < 1472) {
        const int t = idx - 1056;
        d.src = INP(8); d.gain = INP(4); d.dst = (bf16_t*)(ws + OFF_WABIN); d.ldsrc = 3080; d.K = DM; d.k0 = (t & 15) * 64; d.n0 = (t >> 4) * 128; d.mapk = 2;
    } else if (idx < 4768) {
        const int t = idx - 4640;
        d.src = INP(16); d.gain = nullptr; d.dst = (bf16_t*)(ws + OFF_WABOUT); d.ldsrc = DM; d.K = DM; d.k0 = (t & 15) * 64; d.n0 = (t >> 4) * 128; d.mapk = 0;
    } else {
        const int i2 = idx - 4768, g = i2 >> 3, t = i2 & 7;
        d.src = INP(17) + (size_t)g * 65536; d.gain = nullptr; d.dst = (bf16_t*)(ws + OFF_WPOOL) + (size_t)g * 65536; d.ldsrc = 256; d.K = 256; d.k0 = (t & 3) * 64; d.n0 = (t >> 2) * 128; d.mapk = 0;
    }
#undef INP
    return d;
}
__device__ __forceinline__ void tile_load(const Ctx& cx, const TileDesc& d, float (&v)[16], float& g0, float& g1) {
    const int j = cx.tid & 127, i0 = cx.tid >> 7; const int col = tile_map(d.mapk, d.n0 + j);
    g0 = 1.f; g1 = 1.f; if (d.gain) { const int kk2 = (cx.tid & 31) * 2; const GAS float* gp = (const GAS float*)d.gain + d.k0 + kk2; g0 = gp[0]; g1 = gp[1]; }
    const GAS float* sp = (const GAS float*)d.src + (size_t)(d.k0 + i0) * d.ldsrc + (col >= 0 ? col : 0);
#pragma unroll
    for (int ii = 0; ii < 16; ++ii) { v[ii] = 0.f; if (col >= 0) v[ii] = sp[(size_t)(4 * ii) * d.ldsrc]; }
}
__device__ __forceinline__ void tile_store(const Ctx& cx, LAS float* tile, const TileDesc& d, const float (&v)[16], const float g0, const float g1) {
    const int tid = cx.tid;
    { const int j = tid & 127, i0 = tid >> 7;
#pragma unroll
      for (int ii = 0; ii < 16; ++ii) tile[(i0 + 4 * ii) * 129 + j] = v[ii]; }
    LDS_BARRIER();
    { const int kk2 = (tid & 31) * 2, jj0 = tid >> 5;
#pragma unroll
      for (int q = 0; q < 8; ++q) { const int n = jj0 + 16 * q; const unsigned w = pk2(tile[kk2 * 129 + n] * g0, tile[(kk2 + 1) * 129 + n] * g1); *(unsigned*)(d.dst + (size_t)(d.n0 + n) * d.K + d.k0 + kk2) = w; } }
    LDS_BARRIER();
}
template <bool EARLY>
__device__ __forceinline__ void convert_tiles(const Ctx& cx, LAS unsigned char* lds, const Params& p, int first, int last, int wk, int nwk) {
    LAS float* tile = (LAS float*)lds;
    int idx = first + wk;
    if (idx >= last) return;
    TileDesc d = tile_decode<EARLY>(cx, p, idx);
    float v[16], g0, g1; tile_load(cx, d, v, g0, g1);
#pragma unroll 1
    for (;;) {
        const int nidx = idx + nwk; const bool more = nidx < last;
        TileDesc dn = d; float vn[16], gn0 = 1.f, gn1 = 1.f;
        if (more) { dn = tile_decode<EARLY>(cx, p, nidx); tile_load(cx, dn, vn, gn0, gn1); }
        else {
#pragma unroll
            for (int ii = 0; ii < 16; ++ii) vn[ii] = 0.f;
        }
        tile_store(cx, tile, d, v, g0, g1);
        if (!more) break;
        d = dn; idx = nidx; g0 = gn0; g1 = gn1;
#pragma unroll
        for (int ii = 0; ii < 16; ++ii) v[ii] = vn[ii];
    }
}

__device__ __forceinline__ void phase_prologue(const Ctx& cx, LAS unsigned char* lds, const Params& p) {
    unsigned char* ws = cx.ws;
    convert_tiles<true>(cx, lds, p, 0, CT_EARLY, cx.bid, cx.G);
    if (cx.bid == 0 && cx.tid == 0) { const float** tab = (const float**)(ws + OFF_TAB);
#pragma unroll
        for (int i = 0; i < 20; ++i) tab[i] = p.in[i]; }
    if (cx.bid == 0) { float* scl = (float*)(ws + OFF_SCL); for (int i = cx.tid; i < 2048; i += NTHREADS) scl[i] = i < 1024 ? 0.5f : 1.0f; }
    { bf16_t* sgw = (bf16_t*)(ws + OFF_SGW); const float* src = p.in[14];
      for (int i = cx.bid * NTHREADS + cx.tid; i < 4 * 128 * 128; i += cx.G * NTHREADS) { const int s = i & 127, t = (i >> 7) & 127; sgw[i] = (s <= t) ? f2bf(src[i]) : (unsigned short)0; } }
    { const int wave = cx.tid >> 6, lane = cx.tid & 63; const float* x = p.in[0]; bf16_t* xb = (bf16_t*)(ws + OFF_XB); float* ssq = (float*)(ws + OFF_SSQ);
      for (int row = (cx.bid * 8 + wave) * 2; row < MTOK; row += cx.G * 16) {
          const f32x4* src = (const f32x4*)(x + (size_t)row * DM); f32x4 v[8];
#pragma unroll
          for (int q = 0; q < 8; ++q) v[q] = src[lane + 64 * q];
#pragma unroll
          for (int rr = 0; rr < 2; ++rr) {
              float ss = 0.f;
#pragma unroll
              for (int q = 0; q < 4; ++q) { const f32x4 t = v[rr * 4 + q]; ss += (t[0] * t[0] + t[1] * t[1]) + (t[2] * t[2] + t[3] * t[3]);
                  u32x2 w; w.x = pk2(t[0], t[1]); w.y = pk2(t[2], t[3]); *(u32x2*)(xb + (size_t)(row + rr) * DM + (lane + 64 * q) * 4) = w; }
              ss += __shfl_xor(ss, 1); ss += __shfl_xor(ss, 2);
              if ((lane & 3) == 0) ssq[(size_t)(row + rr) * 16 + (lane >> 2)] = ss;
          }
      } }
}

constexpr int PREP_HALF = 54272;
__device__ __forceinline__ void prep_unit(const Ctx& cx, LAS unsigned char* lds, const Params& p, int unit) {
    const int tid = cx.tid, half = tid >> 8, tt = tid & 255, lane = tid & 63, wl = (tid >> 6) & 3, fr = lane & 15, fq = lane >> 4;
    const int hp = unit & 1, n = (unit >> 1) & 127, b = unit >> 8;
    const int h = hp * 2 + half;
    const int uid = (b * 4 + h) * 128 + n;
    const size_t rowbase = (size_t)b * SEQ; const int t0 = n * 64;
    unsigned char* ws = cx.ws;
    LAS unsigned char* L = lds + half * PREP_HALF;
    LAS bf16_t* KB = (LAS bf16_t*)L; LAS bf16_t* QB = (LAS bf16_t*)(L + 17408); LAS float* LF = (LAS float*)(L + 34816);
    LAS float* GC = (LAS float*)(L + 52224); LAS float* BETA = GC + 64; LAS float* RK = GC + 128; LAS float* RQ = GC + 192;
    LAS float* F1 = GC + 256; LAS float* F2 = GC + 320; LAS float* F3 = GC + 384;
    const bf16_t* QKV = (const bf16_t*)(ws + OFF_QKV);
    const float* BA = (const float*)(ws + OFF_BA);
    const float* convw = cx.in[9];
    if (tt < 64) {
        const size_t row = rowbase + t0 + tt;
        const float bv = BA[row * 8 + h], av = BA[row * 8 + 4 + h];
        const float beta = 1.0f / (1.0f + expf(-bv));
        const float A = expf(cx.in[10][h]); const float xx = av + cx.in[11][h];
        const float sp = fmaxf(xx, 0.f) + log1pf(expf(-fabsf(xx)));
        float g = -A * sp;
#pragma unroll
        for (int off = 1; off < 64; off <<= 1) { const float o = __shfl_up(g, off); if (lane >= off) g += o; }
        GC[tt] = g; BETA[tt] = beta;
        if (tt == 63) ((float*)(ws + OFF_EG))[uid] = expf(g);
    }
    LAS bf16_t* RAW = (LAS bf16_t*)L;
    {
        const int rr = tt / 48, seg = tt - rr * 48, w3 = seg >> 4, c8 = (seg & 15) * 8;
        const bf16_t* gp = QKV + ((long)rowbase + t0 - 3 + rr) * 1536 + w3 * 512 + h * 128 + c8;
        LAS bf16_t* lp = RAW + rr * 384 + w3 * 128 + c8;
#pragma unroll
        for (int hb = 0; hb < 1; ++hb) {
            u32x4 x[14];
#pragma unroll
            for (int k = 0; k < 14; ++k) {
                const int kk = hb * 14 + k, r = rr + 5 * kk;
                x[k] = (u32x4){0u, 0u, 0u, 0u};
                if (rr < 5 && r < 67 && (n > 0 || r >= 3)) x[k] = *(const u32x4*)(gp + (long)kk * 5 * 1536);
            }
#pragma unroll
            for (int k = 0; k < 14; ++k) {
                const int kk = hb * 14 + k, r = rr + 5 * kk;
                if (rr < 5 && r < 67) *(LAS u32x4*)(lp + kk * 5 * 384) = x[k];
            }
            asm volatile("" ::: "memory");
        }
    }
    LDS_BARRIER();
    const int which = (wl & 1) ^ half, col = (wl >> 1) * 64 + lane;
    float val[64], qv[32];
    {
        const int srccol = (which ? 512 : 1024) + h * 128 + col;
        const float c0 = convw[srccol], c1 = convw[1536 + srccol], c2 = convw[2 * 1536 + srccol], c3 = convw[3 * 1536 + srccol];
        const LAS bf16_t* src = RAW + 3 * 384 + (which ? 128 : 256) + col;
        float xm3 = bf2f(src[-3 * 384]), xm2 = bf2f(src[-2 * 384]), xm1 = bf2f(src[-1 * 384]);
#pragma unroll
        for (int i16 = 0; i16 < 4; ++i16) {
#pragma unroll
            for (int e = 0; e < 16; ++e) { const int i = i16 * 16 + e; const float xi = bf2f(src[i * 384]); const float y = c0 * xm3 + c1 * xm2 + c2 * xm1 + c3 * xi; val[i] = silu_f(y); xm3 = xm2; xm2 = xm1; xm1 = xi; }
            asm volatile("" ::: "memory");
        }
    }
    const int qt0 = which * 32;
    {
        const int srccol = h * 128 + col;
        const float c0 = convw[srccol], c1 = convw[1536 + srccol], c2 = convw[2 * 1536 + srccol], c3 = convw[3 * 1536 + srccol];
        const LAS bf16_t* src = RAW + (3 + qt0) * 384 + col;
        float xm3 = bf2f(src[-3 * 384]), xm2 = bf2f(src[-2 * 384]), xm1 = bf2f(src[-1 * 384]);
#pragma unroll
        for (int i16 = 0; i16 < 2; ++i16) {
#pragma unroll
            for (int e = 0; e < 16; ++e) { const int i = i16 * 16 + e; const float xi = bf2f(src[i * 384]); const float y = c0 * xm3 + c1 * xm2 + c2 * xm1 + c3 * xi; qv[i] = silu_f(y); xm3 = xm2; xm2 = xm1; xm1 = xi; }
            asm volatile("" ::: "memory");
        }
    }
    LDS_BARRIER();
#pragma unroll
    for (int i = 0; i < 32; ++i) QB[(qt0 + i) * 136 + col] = f2bf(qv[i]);
    if (which) {
#pragma unroll
        for (int i = 0; i < 64; ++i) KB[i * 136 + col] = f2bf(val[i]);
    }
    LDS_BARRIER();
    const int r0 = 16 * wl;
    f32x4 kk[4], qk[4];
    {
        bf16x8 ak[4], aq[4];
#pragma unroll
        for (int ks = 0; ks < 4; ++ks) { ak[ks] = *(const LAS bf16x8*)(KB + (r0 + fr) * 136 + ks * 32 + fq * 8); aq[ks] = *(const LAS bf16x8*)(QB + (r0 + fr) * 136 + ks * 32 + fq * 8); }
        f32x4 kd = {0.f, 0.f, 0.f, 0.f}, qd = {0.f, 0.f, 0.f, 0.f};
#pragma unroll
        for (int ks = 0; ks < 4; ++ks) { kd = MFMA16(ak[ks], ak[ks], kd); qd = MFMA16(aq[ks], aq[ks], qd); }
#pragma unroll
        for (int ct = 0; ct < 4; ++ct) {
            kk[ct] = (f32x4){0.f, 0.f, 0.f, 0.f}; qk[ct] = (f32x4){0.f, 0.f, 0.f, 0.f};
            if (ct <= wl) {
                bf16x8 bk[4];
#pragma unroll
                for (int ks = 0; ks < 4; ++ks) bk[ks] = *(const LAS bf16x8*)(KB + (16 * ct + fr) * 136 + ks * 32 + fq * 8);
                asm volatile("" ::: "memory");
#pragma unroll
                for (int ks = 0; ks < 4; ++ks) { kk[ct] = MFMA16(ak[ks], bk[ks], kk[ct]); qk[ct] = MFMA16(aq[ks], bk[ks], qk[ct]); }
            }
        }
        const float dk = sel4(kd, fr & 3), dq = sel4(qd, fr & 3);
        if ((fr >> 2) == fq) { RK[r0 + fr] = rsqrtf(dk + 1e-6f); RQ[r0 + fr] = rsqrtf(dq + 1e-6f) * 0.08838834764831845f; }
    }
    LDS_BARRIER();
    LAS bf16_t* AT = KB;
    if (tt < 64) { const float g = GC[tt], eg = __expf(g); F1[tt] = RK[tt] * BETA[tt] * eg; F2[tt] = RK[tt] * __expf(GC[63] - g); F3[tt] = RQ[tt] * eg; }
    {
#pragma unroll
        for (int ct = 0; ct < 4; ++ct)
#pragma unroll
            for (int r = 0; r < 4; ++r) {
                const int c = r0 + fq * 4 + r, s = 16 * ct + fr;
                const float dec = __expf(fminf(GC[c] - GC[s], 0.f));
                const float lv = (c > s) ? kk[ct][r] * RK[c] * RK[s] * BETA[c] * dec : 0.f;
                LF[c * 68 + s] = lv;
                const float av = (c >= s) ? qk[ct][r] * RQ[c] * RK[s] * dec : 0.f;
                AT[c * 72 + s] = f2bf(av);
            }
    }
    LDS_BARRIER();
    {
        if (which) {
            bf16_t* KT = (bf16_t*)(ws + OFF_PKT) + (size_t)uid * 8192 + col * 64;
#pragma unroll
            for (int i8 = 0; i8 < 8; ++i8) {
                const f32x4 f2a = *(const LAS f32x4*)(F2 + i8 * 8), f2b = *(const LAS f32x4*)(F2 + i8 * 8 + 4), f1a = *(const LAS f32x4*)(F1 + i8 * 8), f1b = *(const LAS f32x4*)(F1 + i8 * 8 + 4);
                float kt[8];
#pragma unroll
                for (int e = 0; e < 4; ++e) { kt[e] = val[i8 * 8 + e] * f2a[e]; kt[e + 4] = val[i8 * 8 + 4 + e] * f2b[e]; val[i8 * 8 + e] *= f1a[e]; val[i8 * 8 + 4 + e] *= f1b[e]; }
                u32x4 w; w.x = pk2(kt[0], kt[1]); w.y = pk2(kt[2], kt[3]); w.z = pk2(kt[4], kt[5]); w.w = pk2(kt[6], kt[7]);
                *(u32x4*)(KT + i8 * 8) = w;
                asm volatile("" ::: "memory");
            }
        } else {
#pragma unroll
            for (int i8 = 0; i8 < 8; ++i8) {
#pragma unroll
                for (int e = 0; e < 8; ++e) val[i8 * 8 + e] *= BETA[i8 * 8 + e];
                asm volatile("" ::: "memory");
            }
        }
#pragma unroll
        for (int i8 = 0; i8 < 4; ++i8) {
            const f32x4 fa = *(const LAS f32x4*)(F3 + qt0 + i8 * 8), fb = *(const LAS f32x4*)(F3 + qt0 + i8 * 8 + 4);
#pragma unroll
            for (int e = 0; e < 4; ++e) {
                const int t = qt0 + i8 * 8 + e;
                QB[t * 136 + col] = f2bf(bf2f(QB[t * 136 + col]) * fa[e]); QB[(t + 4) * 136 + col] = f2bf(bf2f(QB[(t + 4) * 136 + col]) * fb[e]);
            }
            asm volatile("" ::: "memory");
        }
        bf16_t* ATT = (bf16_t*)(ws + OFF_PATT) + (size_t)uid * 4096;
#pragma unroll
        for (int k = 0; k < 2; ++k) { const int idx = tt + 256 * k, r = idx >> 3, c8 = (idx & 7) * 8; *(u32x4*)(ATT + r * 64 + c8) = *(const LAS u32x4*)(AT + r * 72 + c8); }
    }
#pragma unroll
    for (int i = 1; i < 64; ++i) {
        float a0 = 0.f, a1 = 0.f;
#pragma unroll
        for (int ch = 0; ch < (i + 3) / 4; ++ch) {
            const f32x4 l = *(const LAS f32x4*)(LF + i * 68 + ch * 4);
            a0 = __builtin_fmaf(l[0], val[4 * ch], a0); a1 = __builtin_fmaf(l[1], val[4 * ch + 1], a1);
            a0 = __builtin_fmaf(l[2], val[4 * ch + 2], a0); a1 = __builtin_fmaf(l[3], val[4 * ch + 3], a1);
        }
        val[i] -= (a0 + a1);
        asm volatile("" ::: "memory");
    }
    LDS_BARRIER();
    if (which) {
#pragma unroll
        for (int i = 0; i < 64; ++i) KB[i * 136 + col] = f2bf(val[i]);
    } else {
        bf16_t* UT = (bf16_t*)(ws + OFF_PUT) + (size_t)uid * 8192 + col * 64;
#pragma unroll
        for (int i8 = 0; i8 < 8; ++i8) { u32x4 w; w.x = pk2(val[i8 * 8], val[i8 * 8 + 1]); w.y = pk2(val[i8 * 8 + 2], val[i8 * 8 + 3]); w.z = pk2(val[i8 * 8 + 4], val[i8 * 8 + 5]); w.w = pk2(val[i8 * 8 + 6], val[i8 * 8 + 7]); *(u32x4*)(UT + i8 * 8) = w; }
    }
    LDS_BARRIER();
    {
        bf16_t* W = (bf16_t*)(ws + OFF_PW) + (size_t)uid * 8192;
        bf16_t* QD = (bf16_t*)(ws + OFF_PQD) + (size_t)uid * 8192;
#pragma unroll
        for (int k = 0; k < 4; ++k) { const int idx = tt + 256 * k, r = idx >> 4, c8 = (idx & 15) * 8;
            *(u32x4*)(W + r * 128 + c8) = *(const LAS u32x4*)(KB + r * 136 + c8);
            *(u32x4*)(QD + r * 128 + c8) = *(const LAS u32x4*)(QB + r * 136 + c8); }
    }
    LDS_BARRIER();
}

__device__ __forceinline__ void sg_unit(const Ctx& cx, LAS unsigned char* lds, const Params& p, int unit) {
    const int tid = cx.tid, lane = tid & 63, w = tid >> 6, fr = lane & 15, fq = lane >> 4;
    const int g = unit & 3, nb = (unit >> 2) & 63, b = unit >> 8;
    unsigned char* ws = cx.ws;
    GAS bf16_t* ZUV = (GAS bf16_t*)(ws + OFF_ZUV);
    LAS bf16_t* SVT = (LAS bf16_t*)lds;
    const size_t row0 = (size_t)b * SEQ + nb * 128;
    bf16x8 bw[4];
    { const GAS bf16_t* sgw = (const GAS bf16_t*)(ws + OFF_SGW) + (size_t)g * 16384 + (16 * w + fr) * 128 + fq * 8;
#pragma unroll
      for (int ks = 0; ks < 4; ++ks) bw[ks] = *(const GAS bf16x8*)(sgw + ks * 32); }
    {
        const int s = tid >> 2, qd = tid & 3;
        const GAS u32x4* src = (const GAS u32x4*)(ZUV + (row0 + s) * 1536 + 1024 + g * 128 + qd * 32);
        const GAS f32x4* gnp = (const GAS f32x4*)((const GAS float*)cx.in[13] + g * 128 + qd * 32);
        u32x4 xr[4]; f32x4 gn[8];
#pragma unroll
        for (int q = 0; q < 4; ++q) xr[q] = src[q];
#pragma unroll
        for (int q = 0; q < 8; ++q) gn[q] = gnp[q];
        float v[32]; float ss = 0.f;
#pragma unroll
        for (int q = 0; q < 4; ++q) {
#pragma unroll
            for (int e = 0; e < 4; ++e) { v[q * 8 + 2 * e] = bflo(xr[q][e]); v[q * 8 + 2 * e + 1] = bfhi(xr[q][e]); } }
#pragma unroll
        for (int e = 0; e < 32; ++e) ss += v[e] * v[e];
        ss += __shfl_xor(ss, 1); ss += __shfl_xor(ss, 2);
        const float r = rsqrtf(ss * (1.0f / 128.0f) + 1e-6f);
#pragma unroll
        for (int e = 0; e < 32; ++e) SVT[(qd * 32 + e) * 136 + s] = f2bf(v[e] * r * gn[e >> 2][e & 3]);
    }
    const int t = 16 * w + fr;
    GAS bf16_t* su = ZUV + (row0 + t) * 1536 + 512 + g * 128 + fq * 4;
    u32x2 sux[8];
#pragma unroll
    for (int nt = 0; nt < 8; ++nt) sux[nt] = *(const GAS u32x2*)(su + 16 * nt);
    const float bias = *((const GAS float*)cx.in[15] + g * 128 + t);
    __syncthreads();
    f32x4 acc[8];
#pragma unroll
    for (int nt = 0; nt < 8; ++nt) acc[nt] = (f32x4){0.f, 0.f, 0.f, 0.f};
#pragma unroll
    for (int ks = 0; ks < 4; ++ks) {
        if (ks * 32 <= 16 * w + 15) {
            bf16x8 a[8];
#pragma unroll
            for (int nt = 0; nt < 8; ++nt) a[nt] = *(const LAS bf16x8*)(SVT + (16 * nt + fr) * 136 + ks * 32 + fq * 8);
            asm volatile("" ::: "memory");
#pragma unroll
            for (int nt = 0; nt < 8; ++nt) acc[nt] = MFMA16(a[nt], bw[ks], acc[nt]);
        }
    }
#pragma unroll
    for (int nt = 0; nt < 8; ++nt) {
        const u32x2 x = sux[nt];
        u32x2 o; o.x = pk2(bflo(x.x) * (acc[nt][0] + bias), bfhi(x.x) * (acc[nt][1] + bias)); o.y = pk2(bflo(x.y) * (acc[nt][2] + bias), bfhi(x.y) * (acc[nt][3] + bias));
        *(GAS u32x2*)(su + 16 * nt) = o;
    }
    __syncthreads();
}

struct ScanStage { bf16x8 aw[4]; bf16x8 akt[2]; u32x2 uu; float eg; };
__device__ __forceinline__ void scan_load(ScanStage& st, const bf16_t* PW, const bf16_t* PUT, const bf16_t* PKT, const float* EG, int uid, int w, int mt, int fr, int fq, int dv0) {
    const size_t ub = (size_t)uid * 8192;
    if (w < 4) {
#pragma unroll
        for (int ks = 0; ks < 4; ++ks) st.aw[ks] = *(const GAS bf16x8*)(PW + ub + (16 * mt + fr) * 128 + ks * 32 + fq * 8);
        st.uu = *(const GAS u32x2*)(PUT + ub + (dv0 + fr) * 64 + 16 * mt + fq * 4);
    }
#pragma unroll
    for (int k2 = 0; k2 < 2; ++k2) st.akt[k2] = *(const GAS bf16x8*)(PKT + ub + (16 * w + fr) * 64 + k2 * 32 + fq * 8);
    st.eg = *(const GAS float*)(EG + uid);
}
__device__ __forceinline__ void scan_step(const ScanStage& st, f32x4& S, LAS bf16_t* ST, LAS bf16_t* VT, bf16_t* STT, bf16_t* VNT, int uid, bool last, int w, int mt, int fr, int fq, int dv0) {
    if (w < 4) {
        f32x4 T = {0.f, 0.f, 0.f, 0.f};
        bf16x8 bs[4];
#pragma unroll
        for (int ks = 0; ks < 4; ++ks) bs[ks] = *(const LAS bf16x8*)(ST + fr * 136 + ks * 32 + fq * 8);
        asm volatile("" ::: "memory");
#pragma unroll
        for (int ks = 0; ks < 4; ++ks) T = MFMA16(st.aw[ks], bs[ks], T);
        u32x2 o; o.x = pk2(bflo(st.uu.x) - T[0], bfhi(st.uu.x) - T[1]); o.y = pk2(bflo(st.uu.y) - T[2], bfhi(st.uu.y) - T[3]);
        *(LAS u32x2*)(VT + fr * 72 + 16 * mt + fq * 4) = o;
        *(GAS u32x2*)(VNT + (size_t)uid * 8192 + (dv0 + fr) * 64 + 16 * mt + fq * 4) = o;
    }
    LDS_BARRIER();
    {
        f32x4 acc = S * st.eg;
#pragma unroll
        for (int k2 = 0; k2 < 2; ++k2) { const bf16x8 bv = *(const LAS bf16x8*)(VT + fr * 72 + k2 * 32 + fq * 8); acc = MFMA16(st.akt[k2], bv, acc); }
        S = acc;
        u32x2 o; o.x = pk2(S[0], S[1]); o.y = pk2(S[2], S[3]);
        *(LAS u32x2*)(ST + fr * 136 + 16 * w + fq * 4) = o;
        if (!last) *(GAS u32x2*)(STT + (size_t)(uid + 1) * 16384 + (dv0 + fr) * 128 + 16 * w + fq * 4) = o;
    }
    LDS_BARRIER();
}
__device__ __forceinline__ void phase_scan(const Ctx& cx, LAS unsigned char* lds, const Params& p) {
    if (cx.bid >= 128) return;
    const int tid = cx.tid, lane = tid & 63, w = __builtin_amdgcn_readfirstlane(tid >> 6), fr = lane & 15, fq = lane >> 4;
    const int bh = cx.bid >> 3, dv0 = (cx.bid & 7) * 16;
    unsigned char* ws = cx.ws;
    LAS bf16_t* ST = (LAS bf16_t*)lds;
    LAS bf16_t* VT = (LAS bf16_t*)(lds + 4352);
    const bf16_t* PW = (const bf16_t*)(ws + OFF_PW); const bf16_t* PUT = (const bf16_t*)(ws + OFF_PUT); const bf16_t* PKT = (const bf16_t*)(ws + OFF_PKT);
    const float* EG = (const float*)(ws + OFF_EG);
    bf16_t* STT = (bf16_t*)(ws + OFF_STT); bf16_t* VNT = (bf16_t*)(ws + OFF_VNT);
    for (int i = tid; i < 16 * 136 / 2; i += NTHREADS) ((LAS unsigned*)ST)[i] = 0u;
    f32x4 S = {0.f, 0.f, 0.f, 0.f};
    const int uid0 = bh * 128;
    const int mt = w & 3;
    ScanStage s0, s1, s2, s3;
    scan_load(s0, PW, PUT, PKT, EG, uid0 + 0, w, mt, fr, fq, dv0);
    scan_load(s1, PW, PUT, PKT, EG, uid0 + 1, w, mt, fr, fq, dv0);
    scan_load(s2, PW, PUT, PKT, EG, uid0 + 2, w, mt, fr, fq, dv0);
    scan_load(s3, PW, PUT, PKT, EG, uid0 + 3, w, mt, fr, fq, dv0);
    __syncthreads();
#pragma unroll 1
    for (int n = 0; n < 128; n += 4) {
        scan_step(s0, S, ST, VT, STT, VNT, uid0 + n, false, w, mt, fr, fq, dv0);
        scan_load(s0, PW, PUT, PKT, EG, uid0 + min(n + 4, 127), w, mt, fr, fq, dv0);
        scan_step(s1, S, ST, VT, STT, VNT, uid0 + n + 1, false, w, mt, fr, fq, dv0);
        scan_load(s1, PW, PUT, PKT, EG, uid0 + min(n + 5, 127), w, mt, fr, fq, dv0);
        scan_step(s2, S, ST, VT, STT, VNT, uid0 + n + 2, false, w, mt, fr, fq, dv0);
        scan_load(s2, PW, PUT, PKT, EG, uid0 + min(n + 6, 127), w, mt, fr, fq, dv0);
        scan_step(s3, S, ST, VT, STT, VNT, uid0 + n + 3, n + 3 == 127, w, mt, fr, fq, dv0);
        scan_load(s3, PW, PUT, PKT, EG, uid0 + min(n + 7, 127), w, mt, fr, fq, dv0);
    }
}

__device__ __forceinline__ void out_unit(const Ctx& cx, const Params& p, int uid) {
    const int tid = cx.tid, lane = tid & 63, wl = (tid >> 6) & 3, fr = lane & 15, fq = lane >> 4;
    const int n = uid & 127, h = (uid >> 7) & 3, b = uid >> 9;
    unsigned char* ws = cx.ws;
    const GAS bf16_t* QD = (const GAS bf16_t*)(ws + OFF_PQD) + (size_t)uid * 8192 + (16 * wl + fr) * 128 + fq * 8;
    const GAS bf16_t* ATT = (const GAS bf16_t*)(ws + OFF_PATT) + (size_t)uid * 4096 + (16 * wl + fr) * 64 + fq * 8;
    const GAS bf16_t* STT = (const GAS bf16_t*)(ws + OFF_STT) + (size_t)uid * 16384 + fr * 128 + fq * 8;
    const GAS bf16_t* VNT = (const GAS bf16_t*)(ws + OFF_VNT) + (size_t)uid * 8192 + fr * 64 + fq * 8;
    const size_t row = (size_t)b * SEQ + n * 64 + 16 * wl + fr;
    GAS bf16_t* z = (GAS bf16_t*)(ws + OFF_ZUV) + row * 1536 + h * 128 + fq * 4;
    const bool hasS = n > 0;
    bf16x8 qd[4], at[2], fb[2][6];
#pragma unroll
    for (int ks = 0; ks < 4; ++ks) qd[ks] = *(const GAS bf16x8*)(QD + ks * 32);
#pragma unroll
    for (int k2 = 0; k2 < 2; ++k2) at[k2] = *(const GAS bf16x8*)(ATT + k2 * 32);
#pragma unroll
    for (int ks = 0; ks < 4; ++ks) fb[0][ks] = hasS ? *(const GAS bf16x8*)(STT + ks * 32) : (bf16x8){0, 0, 0, 0, 0, 0, 0, 0};
#pragma unroll
    for (int k2 = 0; k2 < 2; ++k2) fb[0][4 + k2] = *(const GAS bf16x8*)(VNT + k2 * 32);
    f32x4 acc[8];
    u32x2 zx[8];
    f32x4 gnv[8];
    { const GAS float* gn = (const GAS float*)cx.in[12] + fq * 4;
#pragma unroll
      for (int nt = 0; nt < 8; ++nt) gnv[nt] = *(const GAS f32x4*)(gn + 16 * nt); }
#pragma unroll
    for (int nt = 0; nt < 8; ++nt) {
        if (nt < 7) {
#pragma unroll
            for (int ks = 0; ks < 4; ++ks) fb[(nt + 1) & 1][ks] = hasS ? *(const GAS bf16x8*)(STT + (nt + 1) * 16 * 128 + ks * 32) : (bf16x8){0, 0, 0, 0, 0, 0, 0, 0};
#pragma unroll
            for (int k2 = 0; k2 < 2; ++k2) fb[(nt + 1) & 1][4 + k2] = *(const GAS bf16x8*)(VNT + (nt + 1) * 16 * 64 + k2 * 32);
        } else {
#pragma unroll
            for (int q = 0; q < 8; ++q) zx[q] = *(const GAS u32x2*)(z + 16 * q);
        }
        asm volatile("" ::: "memory");
        acc[nt] = (f32x4){0.f, 0.f, 0.f, 0.f};
        if (hasS) {
#pragma unroll
            for (int ks = 0; ks < 4; ++ks) acc[nt] = MFMA16(fb[nt & 1][ks], qd[ks], acc[nt]);
        }
#pragma unroll
        for (int k2 = 0; k2 < 2; ++k2) acc[nt] = MFMA16(fb[nt & 1][4 + k2], at[k2], acc[nt]);
    }
    float ss = 0.f;
#pragma unroll
    for (int nt = 0; nt < 8; ++nt) ss += (acc[nt][0] * acc[nt][0] + acc[nt][1] * acc[nt][1]) + (acc[nt][2] * acc[nt][2] + acc[nt][3] * acc[nt][3]);
    ss += __shfl_xor(ss, 16); ss += __shfl_xor(ss, 32);
    const float rr = rsqrtf(ss * (1.0f / 128.0f) + 1e-6f);
#pragma unroll
    for (int nt = 0; nt < 8; ++nt) {
        const u32x2 x = zx[nt];
        const f32x4 gv = gnv[nt];
        u32x2 o; o.x = pk2(acc[nt][0] * rr * gv[0] * bflo(x.x), acc[nt][1] * rr * gv[1] * bfhi(x.x)); o.y = pk2(acc[nt][2] * rr * gv[2] * bflo(x.y), acc[nt][3] * rr * gv[3] * bfhi(x.y));
        *(GAS u32x2*)(z + 16 * nt) = o;
    }
}

template <int WIN>
__device__ __forceinline__ void pool_body(const GAS bf16_t* xc, const LAS float* RS, float g0, float g1, GAS bf16_t* po, int tb) {
    unsigned xv[64 + WIN - 1];
#pragma unroll
    for (int i = 0; i < 64 + WIN - 1; ++i) { const int t = tb - (WIN - 1) + i; xv[i] = 0u; if (t >= 0) xv[i] = *(const GAS unsigned*)(xc + (long)(i - (WIN - 1)) * DM); }
    float s0 = 0.f, s1 = 0.f;
#pragma unroll
    for (int i = 0; i < WIN - 1; ++i) { const float r = RS[i + 16 - WIN]; s0 += bflo(xv[i]) * r; s1 += bfhi(xv[i]) * r; }
#pragma unroll
    for (int k = 0; k < 64; ++k) {
        const float r = RS[k + 15];
        const float h0 = bflo(xv[k + WIN - 1]) * r, h1 = bfhi(xv[k + WIN - 1]) * r;
        s0 += h0; s1 += h1;
        const int cnt = min(tb + k + 1, WIN);
        const float inv = __builtin_amdgcn_rcpf((float)cnt);
        *(GAS unsigned*)(po + (long)k * 256) = pk2((s0 * inv - h0) * g0, (s1 * inv - h1) * g1);
        const float rl = RS[k + 16 - WIN];
        s0 -= bflo(xv[k]) * rl; s1 -= bfhi(xv[k]) * rl;
    }
}
__device__ __forceinline__ void pool_unit(const Ctx& cx, LAS unsigned char* lds, const Params& p, const bf16_t* X, const float* ssq, int unit) {
    const int tid = cx.tid;
    const int tb = (unit & 127) * 64, b = unit >> 7;
    LAS float* RS = (LAS float*)lds;
    const size_t rowbase = (size_t)b * SEQ;
    if (tid < 79) { const int t = tb - 15 + tid; RS[tid] = (t >= 0) ? rstd_of(ssq, rowbase + t) : 0.f; }
    __syncthreads();
    const int c = tid * 2, g = tid >> 7;
    const float g0 = cx.in[4][DM + c], g1 = cx.in[4][DM + c + 1];
    const GAS bf16_t* xc = (const GAS bf16_t*)X + (rowbase + tb) * DM + c;
    GAS bf16_t* po = (GAS bf16_t*)(cx.ws + OFF_PO) + (size_t)g * MTOK * 256 + (rowbase + tb) * 256 + (c & 255);
    if (g == 0) pool_body<2>(xc, RS, g0, g1, po, tb);
    else if (g == 1) pool_body<4>(xc, RS, g0, g1, po, tb);
    else if (g == 2) pool_body<8>(xc, RS, g0, g1, po, tb);
    else pool_body<16>(xc, RS, g0, g1, po, tb);
    __syncthreads();
}

__device__ __forceinline__ void phase_final(const Ctx& cx, const Params& p, const bf16_t* XB, float* out) {
    const int wave = cx.tid >> 6, lane = cx.tid & 63;
    const float* gw = cx.in[19];
    f32x4 gg[4];
#pragma unroll
    for (int h2 = 0; h2 < 2; ++h2) { gg[2 * h2] = *(const GAS f32x4*)(gw + lane * 8 + h2 * 512); gg[2 * h2 + 1] = *(const GAS f32x4*)(gw + lane * 8 + h2 * 512 + 4); }
    for (int row = (cx.bid * 8 + wave) * 4; row < MTOK; row += cx.G * 32) {
        const GAS bf16_t* xr = (const GAS bf16_t*)XB + (size_t)row * DM + lane * 8;
        u32x4 x[8];
#pragma unroll
        for (int q = 0; q < 8; ++q) x[q] = *(const GAS u32x4*)(xr + (q >> 1) * DM + (q & 1) * 512);
        float ss[4] = {0.f, 0.f, 0.f, 0.f};
#pragma unroll
        for (int q = 0; q < 8; ++q) {
#pragma unroll
            for (int e = 0; e < 4; ++e) { const float lo = bflo(x[q][e]), hi = bfhi(x[q][e]); ss[q >> 1] += lo * lo + hi * hi; }
        }
#pragma unroll
        for (int o = 1; o < 64; o <<= 1) {
#pragma unroll
            for (int r = 0; r < 4; ++r) ss[r] += __shfl_xor(ss[r], o);
        }
#pragma unroll
        for (int q = 0; q < 8; ++q) {
            const float r = rsqrtf(ss[q >> 1] * (1.0f / 1024.0f) + 1e-6f);
            const f32x4 g0 = gg[2 * (q & 1)], g1 = gg[2 * (q & 1) + 1];
            GAS float* o = (GAS float*)out + (size_t)(row + (q >> 1)) * DM + lane * 8 + (q & 1) * 512;
            *(GAS f32x4*)o = (f32x4){bflo(x[q][0]) * r * g0[0], bfhi(x[q][0]) * r * g0[1], bflo(x[q][1]) * r * g0[2], bfhi(x[q][1]) * r * g0[3]};
            *(GAS f32x4*)(o + 4) = (f32x4){bflo(x[q][2]) * r * g1[0], bfhi(x[q][2]) * r * g1[1], bflo(x[q][3]) * r * g1[2], bfhi(x[q][3]) * r * g1[3]};
        }
    }
}

enum { K_PROLOGUE = 0, K_SWIGLU, K_RESID, K_PROJ, K_PREP, K_SCAN, K_OUT, K_POOL, K_FINAL };

__global__ void __launch_bounds__(NTHREADS, 2) fwd_megakernel(Params p) {
    extern __shared__ __attribute__((aligned(16))) unsigned char lds_raw[];
    LAS unsigned char* lds = (LAS unsigned char*)lds_raw;
    cg::grid_group grid = cg::this_grid();
    volatile LAS unsigned* xbst = (volatile LAS unsigned*)(lds + 146432);
    if (threadIdx.x == 0) { xbst[0] = 0u; xbst[1] = 0u; }
    __syncthreads();
    {
        unsigned* bw = (unsigned*)(p.ws + OFF_BAR);
        if (blockIdx.x == 0) {
            for (int i = threadIdx.x; i < 4096; i += NTHREADS) if (i != XB_READY) bw[i] = 0u;
            asm volatile("s_waitcnt vmcnt(0)" ::: "memory");
            __syncthreads();
            if (threadIdx.x == 0) { __builtin_amdgcn_fence(__ATOMIC_RELEASE, "agent"); asm volatile("s_waitcnt vmcnt(0)" ::: "memory"); __hip_atomic_store(&bw[XB_READY], XB_MAGIC, __ATOMIC_RELAXED, __HIP_MEMORY_SCOPE_AGENT); }
        }
        if (threadIdx.x == 0) {
            unsigned sp = 0u;
            while (xb_ld(&bw[XB_READY]) != XB_MAGIC) { __builtin_amdgcn_s_sleep(1); if (++sp > (1u << 20)) break; }
            __builtin_amdgcn_fence(__ATOMIC_ACQUIRE, "agent");
            asm volatile("s_waitcnt vmcnt(0)" ::: "memory");
        }
        __syncthreads();
    }
    if (gridDim.x == 0x7fffffffu) grid.sync();
    const XcdBarrier xbar = xcd_barrier_post((unsigned*)(p.ws + OFF_BAR), xbst);
    { Ctx cx; cx.tid = threadIdx.x; cx.bid = blockIdx.x; cx.G = gridDim.x; cx.ws = p.ws; cx.in = nullptr;
#ifndef NO_PRO
      phase_prologue(cx, lds, p);
#endif
      xcd_barrier(xbar);
      if (blockIdx.x == 0 && threadIdx.x == 0) __hip_atomic_store((unsigned*)(p.ws + OFF_BAR) + XB_READY, 0u, __ATOMIC_RELAXED, __HIP_MEMORY_SCOPE_AGENT); }
#pragma unroll 1
    for (int step = 1; step < 17; ++step) {
        Ctx cx; cx.tid = threadIdx.x; cx.bid = blockIdx.x; cx.G = gridDim.x; cx.ws = p.ws;
        asm volatile("" : "+v"(cx.tid)); asm volatile("" : "+s"(cx.bid)); asm volatile("" : "+s"(cx.G)); asm volatile("" : "+s"(cx.ws));
        cx.in = (const float* const*)(cx.ws + OFF_TAB);
        unsigned char* ws = cx.ws; const int G = cx.G;
        float* X = p.out;
        bf16_t* XB = (bf16_t*)(ws + OFF_XB);
        float* SSQ0 = (float*)(ws + OFF_SSQ); float* SSQ1 = (float*)(ws + OFF_SSQ + SZ_SSQ1);
        int kind = K_PROLOGUE, widx = 0, sidx = 0;
        int rmode = 0;
        switch (step) {
            case 1: kind = K_SWIGLU; widx = 0; sidx = 0; break;
            case 2: kind = K_RESID; widx = 0; sidx = 0; rmode = 0; break;
            case 3: kind = K_PROJ; sidx = 1; break;
            case 4: kind = K_PREP; break;
            case 5: kind = K_SCAN; break;
            case 6: kind = K_OUT; break;
            case 7: kind = K_RESID; sidx = 1; rmode = 1; break;
            case 8: kind = K_SWIGLU; widx = 1; sidx = 0; break;
            case 9: kind = K_RESID; widx = 1; sidx = 0; rmode = 0; break;
            case 10: kind = K_SWIGLU; widx = 2; sidx = 1; break;
            case 11: kind = K_RESID; widx = 2; sidx = 1; rmode = 0; break;
            case 12: kind = K_POOL; sidx = 0; break;
            case 13: kind = K_RESID; sidx = 0; rmode = 2; break;
            case 14: kind = K_SWIGLU; widx = 3; sidx = 1; break;
            case 15: kind = K_RESID; widx = 3; sidx = 1; rmode = 0; break;
            default: kind = K_FINAL; break;
        }
        const float* ssq_in = sidx ? SSQ1 : SSQ0; float* ssq_out = sidx ? SSQ0 : SSQ1;
        if (kind == K_SWIGLU) {
            pg8::Gemm g{XB, (const bf16_t*)(ws + OFF_WFFIN + (size_t)widx * SZ_WFFIN1), MTOK, NFF, DM, DM, 0};
            pg8::StaticOrder S; S.init(MTOK, NFF, G, cx.bid);
            LAS float* RS = (LAS float*)(lds + 131072);
            { pg8::Unit uu; for (int i = 0; i < 15 && S.next(i, uu); ++i) { if (cx.tid < 256) RS[i * 256 + cx.tid] = rstd_of(ssq_in, (size_t)uu.pm * 256 + cx.tid); } __syncthreads(); }
            EpiSwiglu E{(bf16_t*)(ws + OFF_HB), RS, 0};
#ifndef NO_G1
            pg8::gemm_phase<EpiSwiglu, pg8::StaticOrder>(cx.tid, lds, g, S, E);
#endif
        } else if (kind == K_RESID) {
            const float* cs18 = cx.in[18];
            const bf16_t* gA = (const bf16_t*)(ws + (rmode == 0 ? OFF_HB : (rmode == 1 ? OFF_ZUV : OFF_PO)));
            const bf16_t* gB = (const bf16_t*)(ws + (rmode == 0 ? OFF_WFFOUT + (size_t)widx * SZ_WFFOUT1 : (rmode == 1 ? OFF_WABOUT : OFF_WPOOL)));
            const int gK = rmode == 0 ? FF : (rmode == 1 ? DM : 256), glda = rmode == 0 ? FF : (rmode == 1 ? 1536 : 256);
            const size_t gapn = rmode == 2 ? (size_t)MTOK * 256 * 2 : 0;
            const float* cscale = rmode == 2 ? cs18 : (const float*)(ws + OFF_SCL) + (rmode == 1 ? 1024 : 0);
            pg8::Gemm g{gA, gB, MTOK, DM, gK, glda, gapn};
            EpiResid E{XB, ssq_out, cscale};
            pg8::StaticOrder S; S.init(MTOK, DM, G, cx.bid);
#ifndef NO_G2
            pg8::gemm_phase<EpiResid, pg8::StaticOrder>(cx.tid, lds, g, S, E);
#endif
        } else if (kind == K_PROJ) {
            pg8::Gemm g{XB, (const bf16_t*)(ws + OFF_WABIN), MTOK, NPROJ, DM, DM, 0};
            pg8::StaticOrder S; S.init(MTOK, NPROJ, G, cx.bid);
            LAS float* RS = (LAS float*)(lds + 131072);
            { pg8::Unit uu; for (int i = 0; i < 15 && S.next(i, uu); ++i) { if (cx.tid < 256) RS[i * 256 + cx.tid] = rstd_of(ssq_in, (size_t)uu.pm * 256 + cx.tid); } __syncthreads(); }
            EpiProj E{(bf16_t*)(ws + OFF_QKV), (bf16_t*)(ws + OFF_ZUV), (float*)(ws + OFF_BA), RS, 0};
#ifndef NO_G3
            pg8::gemm_phase<EpiProj, pg8::StaticOrder>(cx.tid, lds, g, S, E);
#endif
        } else if (kind == K_PREP) {
#pragma unroll 1
#ifndef NO_PREP
            for (int u = cx.bid; u < 1024; u += G) prep_unit(cx, lds, p, u);
#else
            for (int u = cx.bid; u < 0; u += G) {}
#endif
        } else if (kind == K_SCAN) {
#ifndef NO_SCAN
            if (cx.bid >= 128) {
                convert_tiles<false>(cx, lds, p, CT_EARLY, CT_ALL, cx.bid - 128, G - 128);
#pragma unroll 1
                for (int u = cx.bid - 128; u < 1024; u += G - 128) sg_unit(cx, lds, p, u);
            }
            phase_scan(cx, lds, p);
#endif
        } else if (kind == K_OUT) {
#pragma unroll 1
#ifndef NO_OUT
            for (int u = cx.bid; u < 1024; u += G) out_unit(cx, p, 2 * u + (cx.tid >> 8));
#else
            for (int u = cx.bid; u < 0; u += G) {}
#endif
        } else if (kind == K_POOL) {
#pragma unroll 1
#ifndef NO_POOL
            for (int u = cx.bid; u < 512; u += G) pool_unit(cx, lds, p, XB, ssq_in, u);
#else
            for (int u = cx.bid; u < 0; u += G) {}
#endif
        } else {
#ifndef NO_FIN
            phase_final(cx, p, XB, X);
#endif
        }
        if (step < 16) xcd_barrier(xbar);
    }
}

extern "C" void kernel_launch(void* const* d_in, const int* in_sizes, int n_in, void* d_out, int out_size, void* d_ws, size_t ws_size, hipStream_t stream) {
    static int grid_blocks = 0;
    if (grid_blocks == 0) {
        if (n_in != 20 || ws_size < WS_END) { fprintf(stderr, "kernel_launch: need 20 inputs and %zu bytes of workspace (got %d, %zu)\n", (size_t)WS_END, n_in, ws_size); grid_blocks = -1; return; }
        int dev = 0, cus = 0, per_cu = 0;
        (void)hipGetDevice(&dev);
        (void)hipDeviceGetAttribute(&cus, hipDeviceAttributeMultiprocessorCount, dev);
        if (hipFuncSetAttribute((const void*)fwd_megakernel, hipFuncAttributeMaxDynamicSharedMemorySize, LDS_BYTES) != hipSuccess) { fprintf(stderr, "kernel_launch: hipFuncSetAttribute failed\n"); grid_blocks = -1; return; }
        if (hipOccupancyMaxActiveBlocksPerMultiprocessor(&per_cu, (const void*)fwd_megakernel, NTHREADS, LDS_BYTES) != hipSuccess || per_cu < 1) per_cu = 1;
        (void)hipGetLastError();
        grid_blocks = cus * 1;
        if (grid_blocks < 128) { fprintf(stderr, "kernel_launch: needs >= 128 CUs\n"); grid_blocks = -1; return; }
    }
    if (grid_blocks < 0) return;
    Params p{};
    for (int i = 0; i < 20; ++i) p.in[i] = (const float*)d_in[i];
    p.out = (float*)d_out; p.ws = (unsigned char*)d_ws;
    void* args[] = {&p};
    hipError_t e = hipLaunchCooperativeKernel((const void*)fwd_megakernel, dim3(grid_blocks), dim3(NTHREADS), args, LDS_BYTES, stream);
    if (e != hipSuccess) fprintf(stderr, "cooperative launch failed: %s (grid %d)\n", hipGetErrorString(e), grid_blocks);
}
```

```cpp
#include <hip/hip_runtime.h>
#include <hip/hip_cooperative_groups.h>
#include <cstdio>
namespace pg8 {
#define PG8_LAS __attribute__((address_space(3)))
typedef unsigned short bf16_t;
typedef short bf16x8 __attribute__((ext_vector_type(8)));
typedef float f32x4 __attribute__((ext_vector_type(4)));
typedef unsigned u32x4 __attribute__((ext_vector_type(4)));
constexpr int BM = 256, BK = 64, HALF = 128, HTB = HALF * BK * 2  , STAGE_BYTES = 8 * HTB, NXCD = 8, WGM = 8;

__host__ __device__ __forceinline__ int lds_byte(int r, int c) { const int st = (r >> 4) * 2 + (c >> 5), rr = r & 15, cc = c & 31, ob = rr * 64 + cc * 2; return st * 1024 + (ob ^ (((ob >> 9) & 1) << 5)); }
__host__ __device__ __forceinline__ void stage_rc(int b, int& R, int& C) { const int st = b / 1024, sb = b % 1024, swz = sb ^ (((sb >> 9) & 1) << 5); R = (st >> 1) * 16 + swz / 64; C = (st & 1) * 32 + (swz % 64) / 2; }
__host__ __device__ __forceinline__ int perm32(int rho) { const int n = rho >> 4, i = rho & 15; return 8 * (i >> 2) + 4 * n + (i & 3); }

struct Unit { int pm, pn; };
struct Gemm { const bf16_t* A; const bf16_t* Bt; int M, N, K; int lda; size_t a_pn_bytes; };

struct StaticOrder {
    int nM, nN, nwg, G, c;
    __host__ __device__ void init(int M, int N, int G_, int c_) { nM = M / BM; nN = N / BM; nwg = nM * nN; G = G_; c = c_; }
    __host__ __device__ bool next(int i, Unit& u) const {
        const long L = (long)i * G + c; if (L >= nwg) return false;
        int wgid = (int)L; { const int q = nwg / NXCD, r = nwg % NXCD, xcd = wgid % NXCD, off = wgid / NXCD; wgid = (xcd < r ? xcd * (q + 1) : r * (q + 1) + (xcd - r) * q) + off; }
        const int nig = WGM * nN, gid = wgid / nig, fm = gid * WGM, gsz = (nM - fm) < WGM ? (nM - fm) : WGM;
        u.pm = fm + ((wgid % nig) % gsz); u.pn = (wgid % nig) / gsz; return true;
    }
    __device__ __forceinline__ void a_ready(const Unit&) const {}
    __device__ __forceinline__ void done(const Unit&) const {}
};
__device__ __forceinline__ unsigned cvt_pk_bf16(float lo, float hi) { unsigned r; asm volatile("v_cvt_pk_bf16_f32 %0, %1, %2" : "=v"(r) : "v"(lo), "v"(hi)); return r; }
typedef float f32x2 __attribute__((ext_vector_type(2)));
__device__ __forceinline__ f32x2 gelu_pk(f32x2 v) {
    const f32x2 av = __builtin_elementwise_abs(v), d = av * 0.2316418882f + 1.0f;
    f32x2 t; t.x = __builtin_amdgcn_rcpf(d.x); t.y = __builtin_amdgcn_rcpf(d.y);
    f32x2 q = t * 0.5307027145f + (-0.7265760135f); q = q * t + 0.7107068705f; q = q * t + (-0.142248368f); q = q * t + 0.127414796f; q = q * t;
    const f32x2 s = (v * v) * (-0.72134752044f);
    f32x2 e; e.x = __builtin_amdgcn_exp2f(s.x); e.y = __builtin_amdgcn_exp2f(s.y);
    const f32x2 m = v * (q * e), r = v - m;
    f32x2 o; o.x = v.x < 0.f ? m.x : r.x; o.y = v.y < 0.f ? m.y : r.y; return o;
}

template <class Epi, class Sched>
__device__ __forceinline__ void gemm_phase(const int tid, PG8_LAS unsigned char* lds, const Gemm g, const Sched& S, const Epi& E) {
    const int wid = __builtin_amdgcn_readfirstlane(tid >> 6), lane = tid & 63, wr = wid >> 2, wc = wid & 3, fr = lane & 15, fq = lane >> 4;
    const int K = g.K, nt = K / BK;
    unsigned voffA[2], voffB[2];
#pragma unroll
    for (int i = 0; i < 2; ++i) { int R, C; stage_rc(tid * 16 + i * 8192, R, C); const int Rb = Epi::PERM ? ((R & ~31) + perm32(R & 31)) : R;
        voffA[i] = (unsigned)(R * g.lda + C) * 2u; voffB[i] = (unsigned)(Rb * K + C) * 2u; }
    const size_t kstep = (size_t)(BK * 2);
    const size_t hstepA = (size_t)HALF * g.lda * 2, hstepB = (size_t)HALF * K * 2;
    const size_t tstepA = 2 * hstepA, tstepB = 2 * hstepB;
    const unsigned ldsw = (unsigned)wid * 1024u;
    const int aoff = lds_byte(wr * 64 + fr, fq * 8), boff = lds_byte(wc * 32 + fr, fq * 8);
#define PG8_SA(b, h) (((b) * 2 + (h)) * HTB)
#define PG8_SB(b, h) ((4 + (b) * 2 + (h)) * HTB)
#define PG8_STAGE(bufoff, gbase, voff) do { const char* _sb = (const char*)(gbase); asm volatile("" : "+s"(_sb));   \
        _Pragma("unroll") for (int _i = 0; _i < 2; ++_i) \
        __builtin_amdgcn_global_load_lds((const unsigned*)(_sb + (voff)[_i]), (PG8_LAS unsigned*)(lds + (bufoff) + ldsw + _i * 8192), 16, 0, 0); } while (0)
#define PG8_LDA(dst, b, h) do { _Pragma("unroll") for (int m = 0; m < 4; ++m) _Pragma("unroll") for (int k = 0; k < 2; ++k) dst[m][k] = *(const PG8_LAS bf16x8*)(lds + PG8_SA(b, h) + aoff + m * 2048 + k * 1024); } while (0)
#define PG8_LDB(dst, b, h) do { _Pragma("unroll") for (int n = 0; n < 2; ++n) _Pragma("unroll") for (int k = 0; k < 2; ++k) dst[n][k] = *(const PG8_LAS bf16x8*)(lds + PG8_SB(b, h) + boff + n * 2048 + k * 1024); } while (0)
#define PG8_MMA(ai, bj, At, Bt) do { __builtin_amdgcn_s_setprio(1); _Pragma("unroll") for (int m = 0; m < 4; ++m) _Pragma("unroll") for (int n = 0; n < 2; ++n) _Pragma("unroll") for (int k = 0; k < 2; ++k) \
        acc[ai][bj][m][n] = __builtin_amdgcn_mfma_f32_16x16x32_bf16(Bt[n][k], At[m][k], acc[ai][bj][m][n], 0, 0, 0); __builtin_amdgcn_s_setprio(0); } while (0)
#define PG8_WAIT_V(n) asm volatile("s_waitcnt vmcnt(" #n ")" ::: "memory")
#define PG8_WAIT_L(n) asm volatile("s_waitcnt lgkmcnt(" #n ")" ::: "memory")
#define PG8_BAR __builtin_amdgcn_s_barrier()
#define PG8_SCHED __builtin_amdgcn_sched_barrier(0)
    Unit cur, nxt; int ui = 0;
    if (!S.next(0, cur)) return;
    f32x4 acc[2][2][4][2];
#pragma unroll
    for (int a = 0; a < 2; ++a)
#pragma unroll
        for (int b = 0; b < 2; ++b)
#pragma unroll
            for (int m = 0; m < 4; ++m)
#pragma unroll
                for (int n = 0; n < 2; ++n) acc[a][b][m][n] = (f32x4){0.f, 0.f, 0.f, 0.f};
    bf16x8 At[4][2], B0[2][2], B1[2][2];
    const char* cA = (const char*)g.A + (size_t)cur.pm * tstepA + (size_t)cur.pn * g.a_pn_bytes; const char* cB = (const char*)g.Bt + (size_t)cur.pn * tstepB;
    S.a_ready(cur);
    PG8_STAGE(PG8_SB(0, 0), cB, voffB); PG8_STAGE(PG8_SB(0, 1), cB + hstepB, voffB); PG8_STAGE(PG8_SA(0, 0), cA, voffA); PG8_STAGE(PG8_SA(0, 1), cA + hstepA, voffA);
    if (wr == 1) PG8_BAR;
    PG8_WAIT_V(2); PG8_BAR;
    PG8_STAGE(PG8_SB(1, 0), cB + kstep, voffB); PG8_STAGE(PG8_SA(1, 0), cA + kstep, voffA); PG8_STAGE(PG8_SB(1, 1), cB + hstepB + kstep, voffB);
    PG8_WAIT_V(6); PG8_BAR;
    for (;;) {
        const bool has_next = S.next(ui + 1, nxt);
        const char* nA = has_next ? (const char*)g.A + (size_t)nxt.pm * tstepA + (size_t)nxt.pn * g.a_pn_bytes : cA; const char* nB = has_next ? (const char*)g.Bt + (size_t)nxt.pn * tstepB : cB;
        for (int t = 0; t < nt; t += 2) {
            const bool last = (t == nt - 2);
            const char* a1 = cA + (size_t)(t + 1) * kstep;
            const char* a2 = last ? nA : cA + (size_t)(t + 2) * kstep; const char* b2 = last ? nB : cB + (size_t)(t + 2) * kstep;
            const char* a3 = a2 + kstep; const char* b3 = b2 + kstep;
            if (last && has_next) S.a_ready(nxt);
            PG8_LDB(B0, 0, 0); PG8_LDB(B1, 0, 1); PG8_SCHED; PG8_LDA(At, 0, 0); PG8_STAGE(PG8_SA(1, 1), a1 + hstepA, voffA);
            PG8_WAIT_V(8); PG8_WAIT_L(0); PG8_BAR; PG8_MMA(0, 0, At, B0); PG8_MMA(0, 1, At, B1); PG8_BAR; PG8_SCHED;
            PG8_LDA(At, 0, 1); PG8_STAGE(PG8_SB(0, 0), b2, voffB); PG8_STAGE(PG8_SB(0, 1), b2 + hstepB, voffB); PG8_STAGE(PG8_SA(0, 0), a2, voffA);
            PG8_WAIT_V(8); PG8_WAIT_L(0); PG8_BAR; PG8_MMA(1, 0, At, B0); PG8_MMA(1, 1, At, B1); PG8_BAR; PG8_SCHED;
            PG8_LDB(B0, 1, 0); PG8_LDB(B1, 1, 1); PG8_SCHED; PG8_LDA(At, 1, 0); PG8_STAGE(PG8_SA(0, 1), a2 + hstepA, voffA);
            PG8_WAIT_V(8); PG8_WAIT_L(0); PG8_BAR; PG8_MMA(0, 0, At, B0); PG8_MMA(0, 1, At, B1); PG8_BAR; PG8_SCHED;
            PG8_LDA(At, 1, 1); PG8_STAGE(PG8_SB(1, 0), b3, voffB); PG8_STAGE(PG8_SB(1, 1), b3 + hstepB, voffB); PG8_STAGE(PG8_SA(1, 0), a3, voffA);
            PG8_WAIT_V(8); PG8_WAIT_L(0); PG8_BAR; PG8_MMA(1, 0, At, B0); PG8_MMA(1, 1, At, B1); PG8_BAR; PG8_SCHED;
        }
        if (wr == 0) PG8_BAR;
        if constexpr (!Epi::AFTER_DRAIN) { E(acc, cur, wr, wc, fr, fq); S.done(cur); }
        if (!has_next) break;
#pragma unroll
        for (int a = 0; a < 2; ++a)
#pragma unroll
            for (int b = 0; b < 2; ++b)
#pragma unroll
                for (int m = 0; m < 4; ++m)
#pragma unroll
                    for (int n = 0; n < 2; ++n) acc[a][b][m][n] = (f32x4){0.f, 0.f, 0.f, 0.f};
        cur = nxt; cA = nA; cB = nB; ++ui;
        if (wr == 1) PG8_BAR;
    }
    PG8_WAIT_V(0);
    PG8_BAR;
    if constexpr (Epi::AFTER_DRAIN) { E.fused(acc, cur, wr, wc, fr, fq, lds, wid, lane); S.done(cur); }
#undef PG8_SA
#undef PG8_SB
#undef PG8_STAGE
#undef PG8_LDA
#undef PG8_LDB
#undef PG8_MMA
#undef PG8_WAIT_V
#undef PG8_WAIT_L
#undef PG8_BAR
#undef PG8_SCHED
}
}


namespace cg = cooperative_groups;
using pg8::bf16_t; using pg8::bf16x8; using pg8::f32x4; using pg8::u32x4; using pg8::f32x2;
#define LAS __attribute__((address_space(3)))
#define GAS __attribute__((address_space(1)))
typedef unsigned u32x2 __attribute__((ext_vector_type(2)));

constexpr int MTOK = 32768, DM = 1024, FF = 2816, NFF = 5632, SEQ = 8192, NPROJ = 3328;
constexpr int LDS_BYTES = 144 * 1024;
constexpr int NTHREADS = 512;

constexpr size_t SZ_WFFIN1 = (size_t)NFF * DM * 2, SZ_WFFOUT1 = (size_t)DM * FF * 2;
constexpr size_t OFF_WFFIN = 0;
constexpr size_t OFF_WFFOUT = OFF_WFFIN + 4 * SZ_WFFIN1;
constexpr size_t OFF_WABIN = OFF_WFFOUT + 4 * SZ_WFFOUT1;
constexpr size_t OFF_WABOUT = OFF_WABIN + (size_t)NPROJ * DM * 2;
constexpr size_t OFF_WPOOL = OFF_WABOUT + (size_t)DM * DM * 2;
constexpr size_t OFF_SGW = OFF_WPOOL + (size_t)4 * 256 * 256 * 2;
constexpr size_t OFF_XB = OFF_SGW + (size_t)4 * 128 * 128 * 2;
constexpr size_t SZ_SSQ1 = (size_t)MTOK * 16 * 4;
constexpr size_t OFF_SSQ = OFF_XB + (size_t)MTOK * DM * 2;
constexpr size_t OFF_EG = OFF_SSQ + 2 * SZ_SSQ1;
constexpr size_t OFF_TAB = OFF_EG + 8192;
constexpr size_t OFF_SCL = OFF_TAB + 256;
constexpr size_t OFF_BAR = OFF_SCL + 8192;
constexpr size_t OFF_BIG = OFF_BAR + 16384;
constexpr size_t OFF_HB = OFF_BIG;
constexpr size_t OFF_QKV = OFF_BIG;
constexpr size_t OFF_STT = OFF_BIG;
constexpr size_t OFF_VNT = OFF_BIG + (size_t)2048 * 16384 * 2;
constexpr size_t OFF_ZUV = OFF_BIG + (size_t)MTOK * 1536 * 2;
constexpr size_t OFF_BA = OFF_ZUV + (size_t)MTOK * 1536 * 2;
constexpr size_t OFF_PW = OFF_BA + (size_t)MTOK * 8 * 4;
constexpr size_t OFF_PUT = OFF_PW + (size_t)2048 * 8192 * 2;
constexpr size_t OFF_PKT = OFF_PUT + (size_t)2048 * 8192 * 2;
constexpr size_t OFF_PQD = OFF_PKT + (size_t)2048 * 8192 * 2;
constexpr size_t OFF_PATT = OFF_PQD + (size_t)2048 * 8192 * 2;
constexpr size_t OFF_PO = OFF_BIG;
constexpr size_t WS_END = OFF_PATT + (size_t)2048 * 4096 * 2;

struct Params { const float* in[20]; float* out; unsigned char* ws; };
struct Ctx { int tid, bid, G; unsigned char* ws; const float* const* in; };

__device__ __forceinline__ float bf2f(unsigned short b) { return __uint_as_float(((unsigned)b) << 16); }
typedef __bf16 bf16x2v __attribute__((ext_vector_type(2)));
__device__ __forceinline__ unsigned pk2(float lo, float hi) { const f32x2 v = {lo, hi}; const bf16x2v b = __builtin_convertvector(v, bf16x2v); return __builtin_bit_cast(unsigned, b); }
__device__ __forceinline__ unsigned short f2bf(float f) { return (unsigned short)pk2(f, 0.f); }
#define LDS_BARRIER() do { asm volatile("s_waitcnt lgkmcnt(0)" ::: "memory"); __builtin_amdgcn_s_barrier(); asm volatile("" ::: "memory"); } while (0)
__device__ __forceinline__ float bflo(unsigned w) { return __uint_as_float(w << 16); }
__device__ __forceinline__ float bfhi(unsigned w) { return __uint_as_float(w & 0xffff0000u); }
__device__ __forceinline__ float silu_f(float x) { return x * __builtin_amdgcn_rcpf(1.0f + __builtin_amdgcn_exp2f(x * -1.4426950408889634f)); }
__device__ __forceinline__ float rstd_of(const float* ssq, size_t row) {
    const f32x4* s = (const f32x4*)(ssq + row * 16);
    const f32x4 a = s[0], b = s[1], c = s[2], d = s[3];
    const float t = ((a[0] + a[1]) + (a[2] + a[3])) + ((b[0] + b[1]) + (b[2] + b[3])) + ((c[0] + c[1]) + (c[2] + c[3])) + ((d[0] + d[1]) + (d[2] + d[3]));
    return rsqrtf(t * (1.0f / 1024.0f) + 1e-6f);
}
__device__ __forceinline__ float rstd_coop(const float* ssq, size_t row, int fq) {
    const f32x4 a = *(const f32x4*)(ssq + row * 16 + fq * 4);
    float t = (a[0] + a[1]) + (a[2] + a[3]);
    t += __shfl_xor(t, 16); t += __shfl_xor(t, 32);
    return rsqrtf(t * (1.0f / 1024.0f) + 1e-6f);
}
__device__ __forceinline__ float sel4(const f32x4 v, int r) { return r == 0 ? v[0] : (r == 1 ? v[1] : (r == 2 ? v[2] : v[3])); }
#define MFMA16(a, b, c) __builtin_amdgcn_mfma_f32_16x16x32_bf16((a), (b), (c), 0, 0, 0)


#define XB_READY    64
#define XB_MAGIC    0x5EEDBA55u
#define XB_TMO      128
#define XB_XCNT(j)  (256  + 64 * (j))
#define XB_XSUB(j)  (1280 + 64 * (j))
#define XB_XGEN(j)  (2304 + 64 * (j))
#define XB_TOP      3328
#define XB_TOPGEN   3392
#define XCD_BAR_WORDS 3456
#define XB_SPIN_CAP (1u << 18)
__device__ __forceinline__ unsigned xb_ld(unsigned* p)              { return __hip_atomic_load(p, __ATOMIC_RELAXED, __HIP_MEMORY_SCOPE_AGENT); }
__device__ __forceinline__ unsigned xb_add(unsigned* p, unsigned v) { return __hip_atomic_fetch_add(p, v, __ATOMIC_RELAXED, __HIP_MEMORY_SCOPE_AGENT); }
__device__ __forceinline__ unsigned xb_xcc_id() { return (unsigned)__builtin_amdgcn_s_getreg((3 << 11) | 20) & 0xFu; }
#define XB_SPIN(cond, bar) do { unsigned _sp = 0; while (cond) { __builtin_amdgcn_s_sleep(1); \
    if ((++_sp & 255u) == 0u) { if (xb_ld(&(bar)[XB_TMO])) break; if (_sp > XB_SPIN_CAP) { atomicAdd(&(bar)[XB_TMO], 1u); break; } } } } while (0)
struct XcdBarrier { unsigned* bar; unsigned x; volatile LAS unsigned* st; };
__device__ __forceinline__ XcdBarrier xcd_barrier_post(unsigned* bar, volatile LAS unsigned* st) {
    XcdBarrier b; b.bar = bar; b.x = xb_xcc_id(); b.st = st;
    if (threadIdx.x == 0) (void)xb_add(&bar[XB_XCNT(b.x)], 1u);
    return b;
}
__device__ __forceinline__ void xcd_barrier_complete(unsigned* bar, unsigned x, unsigned& nloc, unsigned& nx) {
    const unsigned G = gridDim.x * gridDim.y * gridDim.z;
    unsigned sum, cnt, mine, sp = 0u;
    for (;;) {
        sum = 0u; cnt = 0u; mine = 0u;
#pragma unroll
        for (unsigned j = 0; j < 16; ++j) { const unsigned c = xb_ld(&bar[XB_XCNT(j)]); sum += c; cnt += (c > 0u) ? 1u : 0u; mine = (j == x) ? c : mine; }
        if (sum == G) break;
        __builtin_amdgcn_s_sleep(1);
        if ((++sp & 255u) == 0u) { if (xb_ld(&bar[XB_TMO])) break; if (sp > XB_SPIN_CAP) { atomicAdd(&bar[XB_TMO], 1u); break; } }
    }
    nloc = mine > 0u ? mine : 1u; nx = cnt > 0u ? cnt : 1u;
}
__device__ __forceinline__ void xcd_barrier(const XcdBarrier& b) {
    asm volatile("s_waitcnt vmcnt(0)" ::: "memory");
    __syncthreads();
    if (threadIdx.x == 0) {
        unsigned* bar = b.bar;
        __builtin_amdgcn_s_waitcnt(0);
        unsigned nloc = b.st[0], nx = b.st[1];
        if (nloc == 0u) { xcd_barrier_complete(bar, b.x, nloc, nx); b.st[0] = nloc; b.st[1] = nx; }
        const unsigned old = xb_add(&bar[XB_XSUB(b.x)], 1u);
        const unsigned gen = old / nloc;
        if (old + 1u == (gen + 1u) * nloc) {
            __builtin_amdgcn_fence(__ATOMIC_RELEASE, "agent");
            asm volatile("s_waitcnt vmcnt(0)" ::: "memory");
            const unsigned og = xb_add(&bar[XB_TOP], 1u);
            const unsigned tg = og / nx;
            if (og + 1u == (tg + 1u) * nx) xb_add(&bar[XB_TOPGEN], 1u);
            else XB_SPIN(xb_ld(&bar[XB_TOPGEN]) == tg, bar);
            __builtin_amdgcn_fence(__ATOMIC_ACQUIRE, "agent");
            xb_add(&bar[XB_XGEN(b.x)], 1u);
            asm volatile("s_waitcnt vmcnt(0)" ::: "memory");
        } else {
            XB_SPIN(xb_ld(&bar[XB_XGEN(b.x)]) == gen, bar);
            __builtin_amdgcn_fence(__ATOMIC_ACQUIRE, "agent");
            asm volatile("s_waitcnt vmcnt(0)" ::: "memory");
        }
    }
    __syncthreads();
}

struct EpiSwiglu {
    static constexpr bool PERM = true, AFTER_DRAIN = false;
    bf16_t* H; const LAS float* RS; mutable int ui;
    __device__ __forceinline__ void operator()(const f32x4 (&acc)[2][2][4][2], const pg8::Unit& u, int wr, int wc, int fr, int fq) const {
        const int row0 = u.pm * 256 + wr * 64 + fr, col0 = u.pn * 128 + wc * 32 + 8 * fq;
        const LAS float* rsu = RS + ui * 256 + wr * 64 + fr; ++ui;
#pragma unroll
        for (int ai = 0; ai < 2; ++ai)
#pragma unroll
            for (int m = 0; m < 4; ++m) {
                const size_t row = (size_t)(row0 + ai * 128 + m * 16);
                const float rs = rsu[ai * 128 + m * 16];
                float hv[8];
#pragma unroll
                for (int n = 0; n < 2; ++n)
#pragma unroll
                    for (int j = 0; j < 4; ++j) { const float g = acc[ai][0][m][n][j] * rs, up = acc[ai][1][m][n][j] * rs; hv[n * 4 + j] = silu_f(g) * up; }
                u32x4 w; w.x = pk2(hv[0], hv[1]); w.y = pk2(hv[2], hv[3]); w.z = pk2(hv[4], hv[5]); w.w = pk2(hv[6], hv[7]);
                *(GAS u32x4*)(H + row * FF + col0) = w;
            }
    }
};
struct EpiResid {
    static constexpr bool PERM = true, AFTER_DRAIN = false;
    bf16_t* XB; float* ssq_out; const float* colscale;
    __device__ __forceinline__ void operator()(const f32x4 (&acc)[2][2][4][2], const pg8::Unit& u, int wr, int wc, int fr, int fq) const {
        const int row0 = u.pm * 256 + wr * 64 + fr, col0 = u.pn * 256 + wc * 32 + 8 * fq;
        bf16_t* xb = XB + (size_t)row0 * DM + col0;
        u32x4 xin[2][4][2];
#pragma unroll
        for (int ai = 0; ai < 2; ++ai)
#pragma unroll
            for (int m = 0; m < 4; ++m)
#pragma unroll
                for (int bj = 0; bj < 2; ++bj) xin[ai][m][bj] = *(const GAS u32x4*)(xb + (size_t)(ai * 128 + m * 16) * DM + bj * 128);
        f32x4 cs[2][2];
#pragma unroll
        for (int bj = 0; bj < 2; ++bj)
#pragma unroll
            for (int n = 0; n < 2; ++n) cs[bj][n] = *(const GAS f32x4*)(colscale + col0 + bj * 128 + 4 * n);
#pragma unroll
        for (int ai = 0; ai < 2; ++ai)
#pragma unroll
            for (int m = 0; m < 4; ++m) {
                float ss = 0.f;
#pragma unroll
                for (int bj = 0; bj < 2; ++bj) {
                    const u32x4 x = xin[ai][m][bj];
                    const f32x4 v0 = acc[ai][bj][m][0] * cs[bj][0], v1 = acc[ai][bj][m][1] * cs[bj][1];
                    const float o0 = bflo(x.x) + v0[0], o1 = bfhi(x.x) + v0[1], o2 = bflo(x.y) + v0[2], o3 = bfhi(x.y) + v0[3];
                    const float o4 = bflo(x.z) + v1[0], o5 = bfhi(x.z) + v1[1], o6 = bflo(x.w) + v1[2], o7 = bfhi(x.w) + v1[3];
                    u32x4 w; w.x = pk2(o0, o1); w.y = pk2(o2, o3); w.z = pk2(o4, o5); w.w = pk2(o6, o7);
                    *(GAS u32x4*)(xb + (size_t)(ai * 128 + m * 16) * DM + bj * 128) = w;
                    ss += ((o0 * o0 + o1 * o1) + (o2 * o2 + o3 * o3)) + ((o4 * o4 + o5 * o5) + (o6 * o6 + o7 * o7));
                }
                ss += __shfl_xor(ss, 16); ss += __shfl_xor(ss, 32);
                if (fq == 0) *(GAS float*)(ssq_out + (size_t)(row0 + ai * 128 + m * 16) * 16 + u.pn * 4 + wc) = ss;
            }
    }
};
struct EpiProj {
    static constexpr bool PERM = true, AFTER_DRAIN = false;
    bf16_t* QKV; bf16_t* ZUV; float* BA; const LAS float* RS; mutable int ui;
    __device__ __forceinline__ void operator()(const f32x4 (&acc)[2][2][4][2], const pg8::Unit& u, int wr, int wc, int fr, int fq) const {
        const int row0 = u.pm * 256 + wr * 64 + fr, colw = wc * 32 + 8 * fq;
        const LAS float* rsu = RS + ui * 256 + wr * 64 + fr; ++ui;
        const int pn = u.pn;
#pragma unroll
        for (int ai = 0; ai < 2; ++ai)
#pragma unroll
            for (int m = 0; m < 4; ++m) {
                const size_t row = (size_t)(row0 + ai * 128 + m * 16);
                const float rs = rsu[ai * 128 + m * 16];
#pragma unroll
                for (int bj = 0; bj < 2; ++bj) {
                    f32x4 v0 = acc[ai][bj][m][0] * rs, v1 = acc[ai][bj][m][1] * rs;
                    const int c = pn * 256 + bj * 128 + colw;
                    if (pn < 6) {
                        u32x4 w; w.x = pk2(v0[0], v0[1]); w.y = pk2(v0[2], v0[3]); w.z = pk2(v1[0], v1[1]); w.w = pk2(v1[2], v1[3]);
                        *(GAS u32x4*)(QKV + row * 1536 + c) = w;
                    } else if (pn < 12) {
                        if (pn < 8) {
#pragma unroll
                            for (int j = 0; j < 4; ++j) { v0[j] = silu_f(v0[j]); v1[j] = silu_f(v1[j]); }
                        } else {
                            const f32x2 a = pg8::gelu_pk((f32x2){v0[0], v0[1]}), b = pg8::gelu_pk((f32x2){v0[2], v0[3]}), cc = pg8::gelu_pk((f32x2){v1[0], v1[1]}), d = pg8::gelu_pk((f32x2){v1[2], v1[3]});
                            v0 = (f32x4){a.x, a.y, b.x, b.y}; v1 = (f32x4){cc.x, cc.y, d.x, d.y};
                        }
                        u32x4 w; w.x = pk2(v0[0], v0[1]); w.y = pk2(v0[2], v0[3]); w.z = pk2(v1[0], v1[1]); w.w = pk2(v1[2], v1[3]);
                        *(GAS u32x4*)(ZUV + row * 1536 + (c - 1536)) = w;
                    } else {
                        if (bj == 0 && colw == 0) { *(GAS f32x4*)(BA + row * 8) = v0; *(GAS f32x4*)(BA + row * 8 + 4) = v1; }
                    }
                }
            }
    }
};

struct MapId { __device__ __forceinline__ int operator()(int n) const { return n; } };
struct MapFfn { __device__ __forceinline__ int operator()(int n) const { const int pn = n >> 8, r = n & 255; return r < 128 ? 128 * pn + r : FF + 128 * pn + (r - 128); } };
struct MapAb { __device__ __forceinline__ int operator()(int n) const { return n < 2048 ? n : (n < 3072 ? n + 8 : (n < 3080 ? n - 1024 : -1)); } };

constexpr int CT_EARLY = 1472, CT_ALL = 4800;
struct TileDesc { const float* src; const float* gain; bf16_t* dst; int ldsrc, K, k0, n0, mapk; };
__device__ __forceinline__ int tile_map(int mapk, int n) { return mapk == 0 ? n : (mapk == 1 ? MapFfn()(n) : MapAb()(n)); }
template <bool EARLY>
__device__ __forceinline__ TileDesc tile_decode(const Ctx& cx, const Params& p, int idx) {
#define INP(i) (EARLY ? p.in[i] : cx.in[i])
    unsigned char* ws = cx.ws; TileDesc d;
    if (idx < 704 || (idx >= 1472 && idx < 3584)) {
        const int i2 = idx < 704 ? idx : idx - 1472, w = idx < 704 ? 0 : 1 + i2 / 704, t = i2 % 704, l = w >> 1, which = w & 1;
        d.src = (which ? INP(6) : INP(2)) + (size_t)l * DM * NFF; d.gain = (which ? INP(5) : INP(1)) + l * DM;
        d.dst = (bf16_t*)(ws + OFF_WFFIN + (size_t)w * SZ_WFFIN1); d.ldsrc = NFF; d.K = DM; d.k0 = (t & 15) * 64; d.n0 = (t >> 4) * 128; d.mapk = 1;
    } else if (idx < 1056 || (idx >= 3584 && idx < 4640)) {
        const int i2 = idx < 1056 ? idx - 704 : idx - 3584, w = idx < 1056 ? 0 : 1 + i2 / 352, t = i2 % 352, l = w >> 1, which = w & 1;
        d.src = (which ? INP(7) : INP(3)) + (size_t)l * FF * DM; d.gain = nullptr;
        d.dst = (bf16_t*)(ws + OFF_WFFOUT + (size_t)w * SZ_WFFOUT1); d.ldsrc = DM; d.K = FF; d.k0 = (t % 44) * 64; d.n0 = (t / 44) * 128; d.mapk = 0;
    } else if (idx < 1472) {
        const int t = idx - 1056;
        d.src = INP(8); d.gain = INP(4); d.dst = (bf16_t*)(ws + OFF_WABIN); d.ldsrc = 3080; d.K = DM; d.k0 = (t & 15) * 64; d.n0 = (t >> 4) * 128; d.mapk = 2;
    } else if (idx < 4768) {
        const int t = idx - 4640;
        d.src = INP(16); d.gain = nullptr; d.dst = (bf16_t*)(ws + OFF_WABOUT); d.ldsrc = DM; d.K = DM; d.k0 = (t & 15) * 64; d.n0 = (t >> 4) * 128; d.mapk = 0;
    } else {
        const int i2 = idx - 4768, g = i2 >> 3, t = i2 & 7;
        d.src = INP(17) + (size_t)g * 65536; d.gain = nullptr; d.dst = (bf16_t*)(ws + OFF_WPOOL) + (size_t)g * 65536; d.ldsrc = 256; d.K = 256; d.k0 = (t & 3) * 64; d.n0 = (t >> 2) * 128; d.mapk = 0;
    }
#undef INP
    return d;
}
__device__ __forceinline__ void tile_load(const Ctx& cx, const TileDesc& d, float (&v)[16], float& g0, float& g1) {
    const int j = cx.tid & 127, i0 = cx.tid >> 7; const int col = tile_map(d.mapk, d.n0 + j);
    g0 = 1.f; g1 = 1.f; if (d.gain) { const int kk2 = (cx.tid & 31) * 2; const GAS float* gp = (const GAS float*)d.gain + d.k0 + kk2; g0 = gp[0]; g1 = gp[1]; }
    const GAS float* sp = (const GAS float*)d.src + (size_t)(d.k0 + i0) * d.ldsrc + (col >= 0 ? col : 0);
#pragma unroll
    for (int ii = 0; ii < 16; ++ii) { v[ii] = 0.f; if (col >= 0) v[ii] = sp[(size_t)(4 * ii) * d.ldsrc]; }
}
__device__ __forceinline__ void tile_store(const Ctx& cx, LAS float* tile, const TileDesc& d, const float (&v)[16], const float g0, const float g1) {
    const int tid = cx.tid;
    { const int j = tid & 127, i0 = tid >> 7;
#pragma unroll
      for (int ii = 0; ii < 16; ++ii) tile[(i0 + 4 * ii) * 129 + j] = v[ii]; }
    LDS_BARRIER();
    { const int kk2 = (tid & 31) * 2, jj0 = tid >> 5;
#pragma unroll
      for (int q = 0; q < 8; ++q) { const int n = jj0 + 16 * q; const unsigned w = pk2(tile[kk2 * 129 + n] * g0, tile[(kk2 + 1) * 129 + n] * g1); *(unsigned*)(d.dst + (size_t)(d.n0 + n) * d.K + d.k0 + kk2) = w; } }
    LDS_BARRIER();
}
template <bool EARLY>
__device__ __forceinline__ void convert_tiles(const Ctx& cx, LAS unsigned char* lds, const Params& p, int first, int last, int wk, int nwk) {
    LAS float* tile = (LAS float*)lds;
    int idx = first + wk;
    if (idx >= last) return;
    TileDesc d = tile_decode<EARLY>(cx, p, idx);
    float v[16], g0, g1; tile_load(cx, d, v, g0, g1);
#pragma unroll 1
    for (;;) {
        const int nidx = idx + nwk; const bool more = nidx < last;
        TileDesc dn = d; float vn[16], gn0 = 1.f, gn1 = 1.f;
        if (more) { dn = tile_decode<EARLY>(cx, p, nidx); tile_load(cx, dn, vn, gn0, gn1); }
        else {
#pragma unroll
            for (int ii = 0; ii < 16; ++ii) vn[ii] = 0.f;
        }
        tile_store(cx, tile, d, v, g0, g1);
        if (!more) break;
        d = dn; idx = nidx; g0 = gn0; g1 = gn1;
#pragma unroll
        for (int ii = 0; ii < 16; ++ii) v[ii] = vn[ii];
    }
}

__device__ __forceinline__ void phase_prologue(const Ctx& cx, LAS unsigned char* lds, const Params& p) {
    unsigned char* ws = cx.ws;
    convert_tiles<true>(cx, lds, p, 0, CT_EARLY, cx.bid, cx.G);
    if (cx.bid == 0 && cx.tid == 0) { const float** tab = (const float**)(ws + OFF_TAB);
#pragma unroll
        for (int i = 0; i < 20; ++i) tab[i] = p.in[i]; }
    if (cx.bid == 0) { float* scl = (float*)(ws + OFF_SCL); for (int i = cx.tid; i < 2048; i += NTHREADS) scl[i] = i < 1024 ? 0.5f : 1.0f; }
    { bf16_t* sgw = (bf16_t*)(ws + OFF_SGW); const float* src = p.in[14];
      for (int i = cx.bid * NTHREADS + cx.tid; i < 4 * 128 * 128; i += cx.G * NTHREADS) { const int s = i & 127, t = (i >> 7) & 127; sgw[i] = (s <= t) ? f2bf(src[i]) : (unsigned short)0; } }
    { const int wave = cx.tid >> 6, lane = cx.tid & 63; const float* x = p.in[0]; bf16_t* xb = (bf16_t*)(ws + OFF_XB); float* ssq = (float*)(ws + OFF_SSQ);
      for (int row = (cx.bid * 8 + wave) * 2; row < MTOK; row += cx.G * 16) {
          const f32x4* src = (const f32x4*)(x + (size_t)row * DM); f32x4 v[8];
#pragma unroll
          for (int q = 0; q < 8; ++q) v[q] = src[lane + 64 * q];
#pragma unroll
          for (int rr = 0; rr < 2; ++rr) {
              float ss = 0.f;
#pragma unroll
              for (int q = 0; q < 4; ++q) { const f32x4 t = v[rr * 4 + q]; ss += (t[0] * t[0] + t[1] * t[1]) + (t[2] * t[2] + t[3] * t[3]);
                  u32x2 w; w.x = pk2(t[0], t[1]); w.y = pk2(t[2], t[3]); *(u32x2*)(xb + (size_t)(row + rr) * DM + (lane + 64 * q) * 4) = w; }
              ss += __shfl_xor(ss, 1); ss += __shfl_xor(ss, 2);
              if ((lane & 3) == 0) ssq[(size_t)(row + rr) * 16 + (lane >> 2)] = ss;
          }
      } }
}

constexpr int PREP_HALF = 54272;
__device__ __forceinline__ void prep_unit(const Ctx& cx, LAS unsigned char* lds, const Params& p, int unit) {
    const int tid = cx.tid, half = tid >> 8, tt = tid & 255, lane = tid & 63, wl = (tid >> 6) & 3, fr = lane & 15, fq = lane >> 4;
    const int hp = unit & 1, n = (unit >> 1) & 127, b = unit >> 8;
    const int h = hp * 2 + half;
    const int uid = (b * 4 + h) * 128 + n;
    const size_t rowbase = (size_t)b * SEQ; const int t0 = n * 64;
    unsigned char* ws = cx.ws;
    LAS unsigned char* L = lds + half * PREP_HALF;
    LAS bf16_t* KB = (LAS bf16_t*)L; LAS bf16_t* QB = (LAS bf16_t*)(L + 17408); LAS float* LF = (LAS float*)(L + 34816);
    LAS float* GC = (LAS float*)(L + 52224); LAS float* BETA = GC + 64; LAS float* RK = GC + 128; LAS float* RQ = GC + 192;
    LAS float* F1 = GC + 256; LAS float* F2 = GC + 320; LAS float* F3 = GC + 384;
    const bf16_t* QKV = (const bf16_t*)(ws + OFF_QKV);
    const float* BA = (const float*)(ws + OFF_BA);
    const float* convw = cx.in[9];
    if (tt < 64) {
        const size_t row = rowbase + t0 + tt;
        const float bv = BA[row * 8 + h], av = BA[row * 8 + 4 + h];
        const float beta = 1.0f / (1.0f + expf(-bv));
        const float A = expf(cx.in[10][h]); const float xx = av + cx.in[11][h];
        const float sp = fmaxf(xx, 0.f) + log1pf(expf(-fabsf(xx)));
        float g = -A * sp;
#pragma unroll
        for (int off = 1; off < 64; off <<= 1) { const float o = __shfl_up(g, off); if (lane >= off) g += o; }
        GC[tt] = g; BETA[tt] = beta;
        if (tt == 63) ((float*)(ws + OFF_EG))[uid] = expf(g);
    }
    LAS bf16_t* RAW = (LAS bf16_t*)L;
    {
        const int rr = tt / 48, seg = tt - rr * 48, w3 = seg >> 4, c8 = (seg & 15) * 8;
        const bf16_t* gp = QKV + ((long)rowbase + t0 - 3 + rr) * 1536 + w3 * 512 + h * 128 + c8;
        LAS bf16_t* lp = RAW + rr * 384 + w3 * 128 + c8;
#pragma unroll
        for (int hb = 0; hb < 1; ++hb) {
            u32x4 x[14];
#pragma unroll
            for (int k = 0; k < 14; ++k) {
                const int kk = hb * 14 + k, r = rr + 5 * kk;
                x[k] = (u32x4){0u, 0u, 0u, 0u};
                if (rr < 5 && r < 67 && (n > 0 || r >= 3)) x[k] = *(const u32x4*)(gp + (long)kk * 5 * 1536);
            }
#pragma unroll
            for (int k = 0; k < 14; ++k) {
                const int kk = hb * 14 + k, r = rr + 5 * kk;
                if (rr < 5 && r < 67) *(LAS u32x4*)(lp + kk * 5 * 384) = x[k];
            }
            asm volatile("" ::: "memory");
        }
    }
    LDS_BARRIER();
    const int which = (wl & 1) ^ half, col = (wl >> 1) * 64 + lane;
    float val[64], qv[32];
    {
        const int srccol = (which ? 512 : 1024) + h * 128 + col;
        const float c0 = convw[srccol], c1 = convw[1536 + srccol], c2 = convw[2 * 1536 + srccol], c3 = convw[3 * 1536 + srccol];
        const LAS bf16_t* src = RAW + 3 * 384 + (which ? 128 : 256) + col;
        float xm3 = bf2f(src[-3 * 384]), xm2 = bf2f(src[-2 * 384]), xm1 = bf2f(src[-1 * 384]);
#pragma unroll
        for (int i16 = 0; i16 < 4; ++i16) {
#pragma unroll
            for (int e = 0; e < 16; ++e) { const int i = i16 * 16 + e; const float xi = bf2f(src[i * 384]); const float y = c0 * xm3 + c1 * xm2 + c2 * xm1 + c3 * xi; val[i] = silu_f(y); xm3 = xm2; xm2 = xm1; xm1 = xi; }
            asm volatile("" ::: "memory");
        }
    }
    const int qt0 = which * 32;
    {
        const int srccol = h * 128 + col;
        const float c0 = convw[srccol], c1 = convw[1536 + srccol], c2 = convw[2 * 1536 + srccol], c3 = convw[3 * 1536 + srccol];
        const LAS bf16_t* src = RAW + (3 + qt0) * 384 + col;
        float xm3 = bf2f(src[-3 * 384]), xm2 = bf2f(src[-2 * 384]), xm1 = bf2f(src[-1 * 384]);
#pragma unroll
        for (int i16 = 0; i16 < 2; ++i16) {
#pragma unroll
            for (int e = 0; e < 16; ++e) { const int i = i16 * 16 + e; const float xi = bf2f(src[i * 384]); const float y = c0 * xm3 + c1 * xm2 + c2 * xm1 + c3 * xi; qv[i] = silu_f(y); xm3 = xm2; xm2 = xm1; xm1 = xi; }
            asm volatile("" ::: "memory");
        }
    }
    LDS_BARRIER();
#pragma unroll
    for (int i = 0; i < 32; ++i) QB[(qt0 + i) * 136 + col] = f2bf(qv[i]);
    if (which) {
#pragma unroll
        for (int i = 0; i < 64; ++i) KB[i * 136 + col] = f2bf(val[i]);
    }
    LDS_BARRIER();
    const int r0 = 16 * wl;
    f32x4 kk[4], qk[4];
    {
        bf16x8 ak[4], aq[4];
#pragma unroll
        for (int ks = 0; ks < 4; ++ks) { ak[ks] = *(const LAS bf16x8*)(KB + (r0 + fr) * 136 + ks * 32 + fq * 8); aq[ks] = *(const LAS bf16x8*)(QB + (r0 + fr) * 136 + ks * 32 + fq * 8); }
        f32x4 kd = {0.f, 0.f, 0.f, 0.f}, qd = {0.f, 0.f, 0.f, 0.f};
#pragma unroll
        for (int ks = 0; ks < 4; ++ks) { kd = MFMA16(ak[ks], ak[ks], kd); qd = MFMA16(aq[ks], aq[ks], qd); }
#pragma unroll
        for (int ct = 0; ct < 4; ++ct) {
            kk[ct] = (f32x4){0.f, 0.f, 0.f, 0.f}; qk[ct] = (f32x4){0.f, 0.f, 0.f, 0.f};
            if (ct <= wl) {
                bf16x8 bk[4];
#pragma unroll
                for (int ks = 0; ks < 4; ++ks) bk[ks] = *(const LAS bf16x8*)(KB + (16 * ct + fr) * 136 + ks * 32 + fq * 8);
                asm volatile("" ::: "memory");
#pragma unroll
                for (int ks = 0; ks < 4; ++ks) { kk[ct] = MFMA16(ak[ks], bk[ks], kk[ct]); qk[ct] = MFMA16(aq[ks], bk[ks], qk[ct]); }
            }
        }
        const float dk = sel4(kd, fr & 3), dq = sel4(qd, fr & 3);
        if ((fr >> 2) == fq) { RK[r0 + fr] = rsqrtf(dk + 1e-6f); RQ[r0 + fr] = rsqrtf(dq + 1e-6f) * 0.08838834764831845f; }
    }
    LDS_BARRIER();
    LAS bf16_t* AT = KB;
    if (tt < 64) { const float g = GC[tt], eg = __expf(g); F1[tt] = RK[tt] * BETA[tt] * eg; F2[tt] = RK[tt] * __expf(GC[63] - g); F3[tt] = RQ[tt] * eg; }
    {
#pragma unroll
        for (int ct = 0; ct < 4; ++ct)
#pragma unroll
            for (int r = 0; r < 4; ++r) {
                const int c = r0 + fq * 4 + r, s = 16 * ct + fr;
                const float dec = __expf(fminf(GC[c] - GC[s], 0.f));
                const float lv = (c > s) ? kk[ct][r] * RK[c] * RK[s] * BETA[c] * dec : 0.f;
                LF[c * 68 + s] = lv;
                const float av = (c >= s) ? qk[ct][r] * RQ[c] * RK[s] * dec : 0.f;
                AT[c * 72 + s] = f2bf(av);
            }
    }
    LDS_BARRIER();
    {
        if (which) {
            bf16_t* KT = (bf16_t*)(ws + OFF_PKT) + (size_t)uid * 8192 + col * 64;
#pragma unroll
            for (int i8 = 0; i8 < 8; ++i8) {
                const f32x4 f2a = *(const LAS f32x4*)(F2 + i8 * 8), f2b = *(const LAS f32x4*)(F2 + i8 * 8 + 4), f1a = *(const LAS f32x4*)(F1 + i8 * 8), f1b = *(const LAS f32x4*)(F1 + i8 * 8 + 4);
                float kt[8];
#pragma unroll
                for (int e = 0; e < 4; ++e) { kt[e] = val[i8 * 8 + e] * f2a[e]; kt[e + 4] = val[i8 * 8 + 4 + e] * f2b[e]; val[i8 * 8 + e] *= f1a[e]; val[i8 * 8 + 4 + e] *= f1b[e]; }
                u32x4 w; w.x = pk2(kt[0], kt[1]); w.y = pk2(kt[2], kt[3]); w.z = pk2(kt[4], kt[5]); w.w = pk2(kt[6], kt[7]);
                *(u32x4*)(KT + i8 * 8) = w;
                asm volatile("" ::: "memory");
            }
        } else {
#pragma unroll
            for (int i8 = 0; i8 < 8; ++i8) {
#pragma unroll
                for (int e = 0; e < 8; ++e) val[i8 * 8 + e] *= BETA[i8 * 8 + e];
                asm volatile("" ::: "memory");
            }
        }
#pragma unroll
        for (int i8 = 0; i8 < 4; ++i8) {
            const f32x4 fa = *(const LAS f32x4*)(F3 + qt0 + i8 * 8), fb = *(const LAS f32x4*)(F3 + qt0 + i8 * 8 + 4);
#pragma unroll
            for (int e = 0; e < 4; ++e) {
                const int t = qt0 + i8 * 8 + e;
                QB[t * 136 + col] = f2bf(bf2f(QB[t * 136 + col]) * fa[e]); QB[(t + 4) * 136 + col] = f2bf(bf2f(QB[(t + 4) * 136 + col]) * fb[e]);
            }
            asm volatile("" ::: "memory");
        }
        bf16_t* ATT = (bf16_t*)(ws + OFF_PATT) + (size_t)uid * 4096;
#pragma unroll
        for (int k = 0; k < 2; ++k) { const int idx = tt + 256 * k, r = idx >> 3, c8 = (idx & 7) * 8; *(u32x4*)(ATT + r * 64 + c8) = *(const LAS u32x4*)(AT + r * 72 + c8); }
    }
#pragma unroll
    for (int i = 1; i < 64; ++i) {
        float a0 = 0.f, a1 = 0.f;
#pragma unroll
        for (int ch = 0; ch < (i + 3) / 4; ++ch) {
            const f32x4 l = *(const LAS f32x4*)(LF + i * 68 + ch * 4);
            a0 = __builtin_fmaf(l[0], val[4 * ch], a0); a1 = __builtin_fmaf(l[1], val[4 * ch + 1], a1);
            a0 = __builtin_fmaf(l[2], val[4 * ch + 2], a0); a1 = __builtin_fmaf(l[3], val[4 * ch + 3], a1);
        }
        val[i] -= (a0 + a1);
        asm volatile("" ::: "memory");
    }
    LDS_BARRIER();
    if (which) {
#pragma unroll
        for (int i = 0; i < 64; ++i) KB[i * 136 + col] = f2bf(val[i]);
    } else {
        bf16_t* UT = (bf16_t*)(ws + OFF_PUT) + (size_t)uid * 8192 + col * 64;
#pragma unroll
        for (int i8 = 0; i8 < 8; ++i8) { u32x4 w; w.x = pk2(val[i8 * 8], val[i8 * 8 + 1]); w.y = pk2(val[i8 * 8 + 2], val[i8 * 8 + 3]); w.z = pk2(val[i8 * 8 + 4], val[i8 * 8 + 5]); w.w = pk2(val[i8 * 8 + 6], val[i8 * 8 + 7]); *(u32x4*)(UT + i8 * 8) = w; }
    }
    LDS_BARRIER();
    {
        bf16_t* W = (bf16_t*)(ws + OFF_PW) + (size_t)uid * 8192;
        bf16_t* QD = (bf16_t*)(ws + OFF_PQD) + (size_t)uid * 8192;
#pragma unroll
        for (int k = 0; k < 4; ++k) { const int idx = tt + 256 * k, r = idx >> 4, c8 = (idx & 15) * 8;
            *(u32x4*)(W + r * 128 + c8) = *(const LAS u32x4*)(KB + r * 136 + c8);
            *(u32x4*)(QD + r * 128 + c8) = *(const LAS u32x4*)(QB + r * 136 + c8); }
    }
    LDS_BARRIER();
}

__device__ __forceinline__ void sg_unit(const Ctx& cx, LAS unsigned char* lds, const Params& p, int unit) {
    const int tid = cx.tid, lane = tid & 63, w = tid >> 6, fr = lane & 15, fq = lane >> 4;
    const int g = unit & 3, nb = (unit >> 2) & 63, b = unit >> 8;
    unsigned char* ws = cx.ws;
    GAS bf16_t* ZUV = (GAS bf16_t*)(ws + OFF_ZUV);
    LAS bf16_t* SVT = (LAS bf16_t*)lds;
    const size_t row0 = (size_t)b * SEQ + nb * 128;
    bf16x8 bw[4];
    { const GAS bf16_t* sgw = (const GAS bf16_t*)(ws + OFF_SGW) + (size_t)g * 16384 + (16 * w + fr) * 128 + fq * 8;
#pragma unroll
      for (int ks = 0; ks < 4; ++ks) bw[ks] = *(const GAS bf16x8*)(sgw + ks * 32); }
    {
        const int s = tid >> 2, qd = tid & 3;
        const GAS u32x4* src = (const GAS u32x4*)(ZUV + (row0 + s) * 1536 + 1024 + g * 128 + qd * 32);
        const GAS f32x4* gnp = (const GAS f32x4*)((const GAS float*)cx.in[13] + g * 128 + qd * 32);
        u32x4 xr[4]; f32x4 gn[8];
#pragma unroll
        for (int q = 0; q < 4; ++q) xr[q] = src[q];
#pragma unroll
        for (int q = 0; q < 8; ++q) gn[q] = gnp[q];
        float v[32]; float ss = 0.f;
#pragma unroll
        for (int q = 0; q < 4; ++q) {
#pragma unroll
            for (int e = 0; e < 4; ++e) { v[q * 8 + 2 * e] = bflo(xr[q][e]); v[q * 8 + 2 * e + 1] = bfhi(xr[q][e]); } }
#pragma unroll
        for (int e = 0; e < 32; ++e) ss += v[e] * v[e];
        ss += __shfl_xor(ss, 1); ss += __shfl_xor(ss, 2);
        const float r = rsqrtf(ss * (1.0f / 128.0f) + 1e-6f);
#pragma unroll
        for (int e = 0; e < 32; ++e) SVT[(qd * 32 + e) * 136 + s] = f2bf(v[e] * r * gn[e >> 2][e & 3]);
    }
    const int t = 16 * w + fr;
    GAS bf16_t* su = ZUV + (row0 + t) * 1536 + 512 + g * 128 + fq * 4;
    u32x2 sux[8];
#pragma unroll
    for (int nt = 0; nt < 8; ++nt) sux[nt] = *(const GAS u32x2*)(su + 16 * nt);
    const float bias = *((const GAS float*)cx.in[15] + g * 128 + t);
    __syncthreads();
    f32x4 acc[8];
#pragma unroll
    for (int nt = 0; nt < 8; ++nt) acc[nt] = (f32x4){0.f, 0.f, 0.f, 0.f};
#pragma unroll
    for (int ks = 0; ks < 4; ++ks) {
        if (ks * 32 <= 16 * w + 15) {
            bf16x8 a[8];
#pragma unroll
            for (int nt = 0; nt < 8; ++nt) a[nt] = *(const LAS bf16x8*)(SVT + (16 * nt + fr) * 136 + ks * 32 + fq * 8);
            asm volatile("" ::: "memory");
#pragma unroll
            for (int nt = 0; nt < 8; ++nt) acc[nt] = MFMA16(a[nt], bw[ks], acc[nt]);
        }
    }
#pragma unroll
    for (int nt = 0; nt < 8; ++nt) {
        const u32x2 x = sux[nt];
        u32x2 o; o.x = pk2(bflo(x.x) * (acc[nt][0] + bias), bfhi(x.x) * (acc[nt][1] + bias)); o.y = pk2(bflo(x.y) * (acc[nt][2] + bias), bfhi(x.y) * (acc[nt][3] + bias));
        *(GAS u32x2*)(su + 16 * nt) = o;
    }
    __syncthreads();
}

struct ScanStage { bf16x8 aw[4]; bf16x8 akt[2]; u32x2 uu; float eg; };
__device__ __forceinline__ void scan_load(ScanStage& st, const bf16_t* PW, const bf16_t* PUT, const bf16_t* PKT, const float* EG, int uid, int w, int mt, int fr, int fq, int dv0) {
    const size_t ub = (size_t)uid * 8192;
    if (w < 4) {
#pragma unroll
        for (int ks = 0; ks < 4; ++ks) st.aw[ks] = *(const GAS bf16x8*)(PW + ub + (16 * mt + fr) * 128 + ks * 32 + fq * 8);
        st.uu = *(const GAS u32x2*)(PUT + ub + (dv0 + fr) * 64 + 16 * mt + fq * 4);
    }
#pragma unroll
    for (int k2 = 0; k2 < 2; ++k2) st.akt[k2] = *(const GAS bf16x8*)(PKT + ub + (16 * w + fr) * 64 + k2 * 32 + fq * 8);
    st.eg = *(const GAS float*)(EG + uid);
}
__device__ __forceinline__ void scan_step(const ScanStage& st, f32x4& S, LAS bf16_t* ST, LAS bf16_t* VT, bf16_t* STT, bf16_t* VNT, int uid, bool last, int w, int mt, int fr, int fq, int dv0) {
    if (w < 4) {
        f32x4 T = {0.f, 0.f, 0.f, 0.f};
        bf16x8 bs[4];
#pragma unroll
        for (int ks = 0; ks < 4; ++ks) bs[ks] = *(const LAS bf16x8*)(ST + fr * 136 + ks * 32 + fq * 8);
        asm volatile("" ::: "memory");
#pragma unroll
        for (int ks = 0; ks < 4; ++ks) T = MFMA16(st.aw[ks], bs[ks], T);
        u32x2 o; o.x = pk2(bflo(st.uu.x) - T[0], bfhi(st.uu.x) - T[1]); o.y = pk2(bflo(st.uu.y) - T[2], bfhi(st.uu.y) - T[3]);
        *(LAS u32x2*)(VT + fr * 72 + 16 * mt + fq * 4) = o;
        *(GAS u32x2*)(VNT + (size_t)uid * 8192 + (dv0 + fr) * 64 + 16 * mt + fq * 4) = o;
    }
    LDS_BARRIER();
    {
        f32x4 acc = S * st.eg;
#pragma unroll
        for (int k2 = 0; k2 < 2; ++k2) { const bf16x8 bv = *(const LAS bf16x8*)(VT + fr * 72 + k2 * 32 + fq * 8); acc = MFMA16(st.akt[k2], bv, acc); }
        S = acc;
        u32x2 o; o.x = pk2(S[0], S[1]); o.y = pk2(S[2], S[3]);
        *(LAS u32x2*)(ST + fr * 136 + 16 * w + fq * 4) = o;
        if (!last) *(GAS u32x2*)(STT + (size_t)(uid + 1) * 16384 + (dv0 + fr) * 128 + 16 * w + fq * 4) = o;
    }
    LDS_BARRIER();
}
__device__ __forceinline__ void phase_scan(const Ctx& cx, LAS unsigned char* lds, const Params& p) {
    if (cx.bid >= 128) return;
    const int tid = cx.tid, lane = tid & 63, w = __builtin_amdgcn_readfirstlane(tid >> 6), fr = lane & 15, fq = lane >> 4;
    const int bh = cx.bid >> 3, dv0 = (cx.bid & 7) * 16;
    unsigned char* ws = cx.ws;
    LAS bf16_t* ST = (LAS bf16_t*)lds;
    LAS bf16_t* VT = (LAS bf16_t*)(lds + 4352);
    const bf16_t* PW = (const bf16_t*)(ws + OFF_PW); const bf16_t* PUT = (const bf16_t*)(ws + OFF_PUT); const bf16_t* PKT = (const bf16_t*)(ws + OFF_PKT);
    const float* EG = (const float*)(ws + OFF_EG);
    bf16_t* STT = (bf16_t*)(ws + OFF_STT); bf16_t* VNT = (bf16_t*)(ws + OFF_VNT);
    for (int i = tid; i < 16 * 136 / 2; i += NTHREADS) ((LAS unsigned*)ST)[i] = 0u;
    f32x4 S = {0.f, 0.f, 0.f, 0.f};
    const int uid0 = bh * 128;
    const int mt = w & 3;
    ScanStage s0, s1, s2, s3;
    scan_load(s0, PW, PUT, PKT, EG, uid0 + 0, w, mt, fr, fq, dv0);
    scan_load(s1, PW, PUT, PKT, EG, uid0 + 1, w, mt, fr, fq, dv0);
    scan_load(s2, PW, PUT, PKT, EG, uid0 + 2, w, mt, fr, fq, dv0);
    scan_load(s3, PW, PUT, PKT, EG, uid0 + 3, w, mt, fr, fq, dv0);
    __syncthreads();
#pragma unroll 1
    for (int n = 0; n < 128; n += 4) {
        scan_step(s0, S, ST, VT, STT, VNT, uid0 + n, false, w, mt, fr, fq, dv0);
        scan_load(s0, PW, PUT, PKT, EG, uid0 + min(n + 4, 127), w, mt, fr, fq, dv0);
        scan_step(s1, S, ST, VT, STT, VNT, uid0 + n + 1, false, w, mt, fr, fq, dv0);
        scan_load(s1, PW, PUT, PKT, EG, uid0 + min(n + 5, 127), w, mt, fr, fq, dv0);
        scan_step(s2, S, ST, VT, STT, VNT, uid0 + n + 2, false, w, mt, fr, fq, dv0);
        scan_load(s2, PW, PUT, PKT, EG, uid0 + min(n + 6, 127), w, mt, fr, fq, dv0);
        scan_step(s3, S, ST, VT, STT, VNT, uid0 + n + 3, n + 3 == 127, w, mt, fr, fq, dv0);
        scan_load(s3, PW, PUT, PKT, EG, uid0 + min(n + 7, 127), w, mt, fr, fq, dv0);
    }
}

__device__ __forceinline__ void out_unit(const Ctx& cx, const Params& p, int uid) {
    const int tid = cx.tid, lane = tid & 63, wl = (tid >> 6) & 3, fr = lane & 15, fq = lane >> 4;
    const int n = uid & 127, h = (uid >> 7) & 3, b = uid >> 9;
    unsigned char* ws = cx.ws;
    const GAS bf16_t* QD = (const GAS bf16_t*)(ws + OFF_PQD) + (size_t)uid * 8192 + (16 * wl + fr) * 128 + fq * 8;
    const GAS bf16_t* ATT = (const GAS bf16_t*)(ws + OFF_PATT) + (size_t)uid * 4096 + (16 * wl + fr) * 64 + fq * 8;
    const GAS bf16_t* STT = (const GAS bf16_t*)(ws + OFF_STT) + (size_t)uid * 16384 + fr * 128 + fq * 8;
    const GAS bf16_t* VNT = (const GAS bf16_t*)(ws + OFF_VNT) + (size_t)uid * 8192 + fr * 64 + fq * 8;
    const size_t row = (size_t)b * SEQ + n * 64 + 16 * wl + fr;
    GAS bf16_t* z = (GAS bf16_t*)(ws + OFF_ZUV) + row * 1536 + h * 128 + fq * 4;
    const bool hasS = n > 0;
    bf16x8 qd[4], at[2], fb[2][6];
#pragma unroll
    for (int ks = 0; ks < 4; ++ks) qd[ks] = *(const GAS bf16x8*)(QD + ks * 32);
#pragma unroll
    for (int k2 = 0; k2 < 2; ++k2) at[k2] = *(const GAS bf16x8*)(ATT + k2 * 32);
#pragma unroll
    for (int ks = 0; ks < 4; ++ks) fb[0][ks] = hasS ? *(const GAS bf16x8*)(STT + ks * 32) : (bf16x8){0, 0, 0, 0, 0, 0, 0, 0};
#pragma unroll
    for (int k2 = 0; k2 < 2; ++k2) fb[0][4 + k2] = *(const GAS bf16x8*)(VNT + k2 * 32);
    f32x4 acc[8];
    u32x2 zx[8];
    f32x4 gnv[8];
    { const GAS float* gn = (const GAS float*)cx.in[12] + fq * 4;
#pragma unroll
      for (int nt = 0; nt < 8; ++nt) gnv[nt] = *(const GAS f32x4*)(gn + 16 * nt); }
#pragma unroll
    for (int nt = 0; nt < 8; ++nt) {
        if (nt < 7) {
#pragma unroll
            for (int ks = 0; ks < 4; ++ks) fb[(nt + 1) & 1][ks] = hasS ? *(const GAS bf16x8*)(STT + (nt + 1) * 16 * 128 + ks * 32) : (bf16x8){0, 0, 0, 0, 0, 0, 0, 0};
#pragma unroll
            for (int k2 = 0; k2 < 2; ++k2) fb[(nt + 1) & 1][4 + k2] = *(const GAS bf16x8*)(VNT + (nt + 1) * 16 * 64 + k2 * 32);
        } else {
#pragma unroll
            for (int q = 0; q < 8; ++q) zx[q] = *(const GAS u32x2*)(z + 16 * q);
        }
        asm volatile("" ::: "memory");
        acc[nt] = (f32x4){0.f, 0.f, 0.f, 0.f};
        if (hasS) {
#pragma unroll
            for (int ks = 0; ks < 4; ++ks) acc[nt] = MFMA16(fb[nt & 1][ks], qd[ks], acc[nt]);
        }
#pragma unroll
        for (int k2 = 0; k2 < 2; ++k2) acc[nt] = MFMA16(fb[nt & 1][4 + k2], at[k2], acc[nt]);
    }
    float ss = 0.f;
#pragma unroll
    for (int nt = 0; nt < 8; ++nt) ss += (acc[nt][0] * acc[nt][0] + acc[nt][1] * acc[nt][1]) + (acc[nt][2] * acc[nt][2] + acc[nt][3] * acc[nt][3]);
    ss += __shfl_xor(ss, 16); ss += __shfl_xor(ss, 32);
    const float rr = rsqrtf(ss * (1.0f / 128.0f) + 1e-6f);
#pragma unroll
    for (int nt = 0; nt < 8; ++nt) {
        const u32x2 x = zx[nt];
        const f32x4 gv = gnv[nt];
        u32x2 o; o.x = pk2(acc[nt][0] * rr * gv[0] * bflo(x.x), acc[nt][1] * rr * gv[1] * bfhi(x.x)); o.y = pk2(acc[nt][2] * rr * gv[2] * bflo(x.y), acc[nt][3] * rr * gv[3] * bfhi(x.y));
        *(GAS u32x2*)(z + 16 * nt) = o;
    }
}

template <int WIN>
__device__ __forceinline__ void pool_body(const GAS bf16_t* xc, const LAS float* RS, float g0, float g1, GAS bf16_t* po, int tb) {
    unsigned xv[64 + WIN - 1];
#pragma unroll
    for (int i = 0; i < 64 + WIN - 1; ++i) { const int t = tb - (WIN - 1) + i; xv[i] = 0u; if (t >= 0) xv[i] = *(const GAS unsigned*)(xc + (long)(i - (WIN - 1)) * DM); }
    float s0 = 0.f, s1 = 0.f;
#pragma unroll
    for (int i = 0; i < WIN - 1; ++i) { const float r = RS[i + 16 - WIN]; s0 += bflo(xv[i]) * r; s1 += bfhi(xv[i]) * r; }
#pragma unroll
    for (int k = 0; k < 64; ++k) {
        const float r = RS[k + 15];
        const float h0 = bflo(xv[k + WIN - 1]) * r, h1 = bfhi(xv[k + WIN - 1]) * r;
        s0 += h0; s1 += h1;
        const int cnt = min(tb + k + 1, WIN);
        const float inv = __builtin_amdgcn_rcpf((float)cnt);
        *(GAS unsigned*)(po + (long)k * 256) = pk2((s0 * inv - h0) * g0, (s1 * inv - h1) * g1);
        const float rl = RS[k + 16 - WIN];
        s0 -= bflo(xv[k]) * rl; s1 -= bfhi(xv[k]) * rl;
    }
}
__device__ __forceinline__ void pool_unit(const Ctx& cx, LAS unsigned char* lds, const Params& p, const bf16_t* X, const float* ssq, int unit) {
    const int tid = cx.tid;
    const int tb = (unit & 127) * 64, b = unit >> 7;
    LAS float* RS = (LAS float*)lds;
    const size_t rowbase = (size_t)b * SEQ;
    if (tid < 79) { const int t = tb - 15 + tid; RS[tid] = (t >= 0) ? rstd_of(ssq, rowbase + t) : 0.f; }
    __syncthreads();
    const int c = tid * 2, g = tid >> 7;
    const float g0 = cx.in[4][DM + c], g1 = cx.in[4][DM + c + 1];
    const GAS bf16_t* xc = (const GAS bf16_t*)X + (rowbase + tb) * DM + c;
    GAS bf16_t* po = (GAS bf16_t*)(cx.ws + OFF_PO) + (size_t)g * MTOK * 256 + (rowbase + tb) * 256 + (c & 255);
    if (g == 0) pool_body<2>(xc, RS, g0, g1, po, tb);
    else if (g == 1) pool_body<4>(xc, RS, g0, g1, po, tb);
    else if (g == 2) pool_body<8>(xc, RS, g0, g1, po, tb);
    else pool_body<16>(xc, RS, g0, g1, po, tb);
    __syncthreads();
}

__device__ __forceinline__ void phase_final(const Ctx& cx, const Params& p, const bf16_t* XB, float* out) {
    const int wave = cx.tid >> 6, lane = cx.tid & 63;
    const float* gw = cx.in[19];
    f32x4 gg[4];
#pragma unroll
    for (int h2 = 0; h2 < 2; ++h2) { gg[2 * h2] = *(const GAS f32x4*)(gw + lane * 8 + h2 * 512); gg[2 * h2 + 1] = *(const GAS f32x4*)(gw + lane * 8 + h2 * 512 + 4); }
    for (int row = (cx.bid * 8 + wave) * 2; row < MTOK; row += cx.G * 16) {
        const GAS bf16_t* xr = (const GAS bf16_t*)XB + (size_t)row * DM + lane * 8;
        u32x4 x[4];
#pragma unroll
        for (int q = 0; q < 4; ++q) x[q] = *(const GAS u32x4*)(xr + (q >> 1) * DM + (q & 1) * 512);
        float v[4][8]; float ss[2] = {0.f, 0.f};
#pragma unroll
        for (int q = 0; q < 4; ++q) {
#pragma unroll
            for (int e = 0; e < 4; ++e) { v[q][2 * e] = bflo(x[q][e]); v[q][2 * e + 1] = bfhi(x[q][e]); }
#pragma unroll
            for (int e = 0; e < 8; ++e) ss[q >> 1] += v[q][e] * v[q][e];
        }
#pragma unroll
        for (int o = 1; o < 64; o <<= 1) { ss[0] += __shfl_xor(ss[0], o); ss[1] += __shfl_xor(ss[1], o); }
        const float r0 = rsqrtf(ss[0] * (1.0f / 1024.0f) + 1e-6f), r1 = rsqrtf(ss[1] * (1.0f / 1024.0f) + 1e-6f);
#pragma unroll
        for (int q = 0; q < 4; ++q) {
            const float r = (q >> 1) ? r1 : r0;
            const f32x4 g0 = gg[2 * (q & 1)], g1 = gg[2 * (q & 1) + 1];
            GAS float* o = (GAS float*)out + (size_t)(row + (q >> 1)) * DM + lane * 8 + (q & 1) * 512;
            *(GAS f32x4*)o = (f32x4){v[q][0] * r * g0[0], v[q][1] * r * g0[1], v[q][2] * r * g0[2], v[q][3] * r * g0[3]};
            *(GAS f32x4*)(o + 4) = (f32x4){v[q][4] * r * g1[0], v[q][5] * r * g1[1], v[q][6] * r * g1[2], v[q][7] * r * g1[3]};
        }
    }
}

enum { K_PROLOGUE = 0, K_SWIGLU, K_RESID, K_PROJ, K_PREP, K_SCAN, K_OUT, K_POOL, K_FINAL };

__global__ void __launch_bounds__(NTHREADS, 2) fwd_megakernel(Params p) {
    extern __shared__ __attribute__((aligned(16))) unsigned char lds_raw[];
    LAS unsigned char* lds = (LAS unsigned char*)lds_raw;
    cg::grid_group grid = cg::this_grid();
    volatile LAS unsigned* xbst = (volatile LAS unsigned*)(lds + 146432);
    if (threadIdx.x == 0) { xbst[0] = 0u; xbst[1] = 0u; }
    __syncthreads();
    {
        unsigned* bw = (unsigned*)(p.ws + OFF_BAR);
        if (blockIdx.x == 0) {
            for (int i = threadIdx.x; i < 4096; i += NTHREADS) if (i != XB_READY) bw[i] = 0u;
            asm volatile("s_waitcnt vmcnt(0)" ::: "memory");
            __syncthreads();
            if (threadIdx.x == 0) { __builtin_amdgcn_fence(__ATOMIC_RELEASE, "agent"); asm volatile("s_waitcnt vmcnt(0)" ::: "memory"); __hip_atomic_store(&bw[XB_READY], XB_MAGIC, __ATOMIC_RELAXED, __HIP_MEMORY_SCOPE_AGENT); }
        }
        if (threadIdx.x == 0) {
            unsigned sp = 0u;
            while (xb_ld(&bw[XB_READY]) != XB_MAGIC) { __builtin_amdgcn_s_sleep(1); if (++sp > (1u << 20)) break; }
            __builtin_amdgcn_fence(__ATOMIC_ACQUIRE, "agent");
            asm volatile("s_waitcnt vmcnt(0)" ::: "memory");
        }
        __syncthreads();
    }
    if (gridDim.x == 0x7fffffffu) grid.sync();
    const XcdBarrier xbar = xcd_barrier_post((unsigned*)(p.ws + OFF_BAR), xbst);
    { Ctx cx; cx.tid = threadIdx.x; cx.bid = blockIdx.x; cx.G = gridDim.x; cx.ws = p.ws; cx.in = nullptr;
#ifndef NO_PRO
      phase_prologue(cx, lds, p);
#endif
      xcd_barrier(xbar);
      if (blockIdx.x == 0 && threadIdx.x == 0) __hip_atomic_store((unsigned*)(p.ws + OFF_BAR) + XB_READY, 0u, __ATOMIC_RELAXED, __HIP_MEMORY_SCOPE_AGENT); }
#pragma unroll 1
    for (int step = 1; step < 17; ++step) {
        Ctx cx; cx.tid = threadIdx.x; cx.bid = blockIdx.x; cx.G = gridDim.x; cx.ws = p.ws;
        asm volatile("" : "+v"(cx.tid)); asm volatile("" : "+s"(cx.bid)); asm volatile("" : "+s"(cx.G)); asm volatile("" : "+s"(cx.ws));
        cx.in = (const float* const*)(cx.ws + OFF_TAB);
        unsigned char* ws = cx.ws; const int G = cx.G;
        float* X = p.out;
        bf16_t* XB = (bf16_t*)(ws + OFF_XB);
        float* SSQ0 = (float*)(ws + OFF_SSQ); float* SSQ1 = (float*)(ws + OFF_SSQ + SZ_SSQ1);
        int kind = K_PROLOGUE, widx = 0, sidx = 0;
        int rmode = 0;
        switch (step) {
            case 1: kind = K_SWIGLU; widx = 0; sidx = 0; break;
            case 2: kind = K_RESID; widx = 0; sidx = 0; rmode = 0; break;
            case 3: kind = K_PROJ; sidx = 1; break;
            case 4: kind = K_PREP; break;
            case 5: kind = K_SCAN; break;
            case 6: kind = K_OUT; break;
            case 7: kind = K_RESID; sidx = 1; rmode = 1; break;
            case 8: kind = K_SWIGLU; widx = 1; sidx = 0; break;
            case 9: kind = K_RESID; widx = 1; sidx = 0; rmode = 0; break;
            case 10: kind = K_SWIGLU; widx = 2; sidx = 1; break;
            case 11: kind = K_RESID; widx = 2; sidx = 1; rmode = 0; break;
            case 12: kind = K_POOL; sidx = 0; break;
            case 13: kind = K_RESID; sidx = 0; rmode = 2; break;
            case 14: kind = K_SWIGLU; widx = 3; sidx = 1; break;
            case 15: kind = K_RESID; widx = 3; sidx = 1; rmode = 0; break;
            default: kind = K_FINAL; break;
        }
        const float* ssq_in = sidx ? SSQ1 : SSQ0; float* ssq_out = sidx ? SSQ0 : SSQ1;
        if (kind == K_SWIGLU) {
            pg8::Gemm g{XB, (const bf16_t*)(ws + OFF_WFFIN + (size_t)widx * SZ_WFFIN1), MTOK, NFF, DM, DM, 0};
            pg8::StaticOrder S; S.init(MTOK, NFF, G, cx.bid);
            LAS float* RS = (LAS float*)(lds + 131072);
            { pg8::Unit uu; for (int i = 0; i < 15 && S.next(i, uu); ++i) { if (cx.tid < 256) RS[i * 256 + cx.tid] = rstd_of(ssq_in, (size_t)uu.pm * 256 + cx.tid); } __syncthreads(); }
            EpiSwiglu E{(bf16_t*)(ws + OFF_HB), RS, 0};
#ifndef NO_G1
            pg8::gemm_phase<EpiSwiglu, pg8::StaticOrder>(cx.tid, lds, g, S, E);
#endif
        } else if (kind == K_RESID) {
            const float* cs18 = cx.in[18];
            const bf16_t* gA = (const bf16_t*)(ws + (rmode == 0 ? OFF_HB : (rmode == 1 ? OFF_ZUV : OFF_PO)));
            const bf16_t* gB = (const bf16_t*)(ws + (rmode == 0 ? OFF_WFFOUT + (size_t)widx * SZ_WFFOUT1 : (rmode == 1 ? OFF_WABOUT : OFF_WPOOL)));
            const int gK = rmode == 0 ? FF : (rmode == 1 ? DM : 256), glda = rmode == 0 ? FF : (rmode == 1 ? 1536 : 256);
            const size_t gapn = rmode == 2 ? (size_t)MTOK * 256 * 2 : 0;
            const float* cscale = rmode == 2 ? cs18 : (const float*)(ws + OFF_SCL) + (rmode == 1 ? 1024 : 0);
            pg8::Gemm g{gA, gB, MTOK, DM, gK, glda, gapn};
            EpiResid E{XB, ssq_out, cscale};
            pg8::StaticOrder S; S.init(MTOK, DM, G, cx.bid);
#ifndef NO_G2
            pg8::gemm_phase<EpiResid, pg8::StaticOrder>(cx.tid, lds, g, S, E);
#endif
        } else if (kind == K_PROJ) {
            pg8::Gemm g{XB, (const bf16_t*)(ws + OFF_WABIN), MTOK, NPROJ, DM, DM, 0};
            pg8::StaticOrder S; S.init(MTOK, NPROJ, G, cx.bid);
            LAS float* RS = (LAS float*)(lds + 131072);
            { pg8::Unit uu; for (int i = 0; i < 15 && S.next(i, uu); ++i) { if (cx.tid < 256) RS[i * 256 + cx.tid] = rstd_of(ssq_in, (size_t)uu.pm * 256 + cx.tid); } __syncthreads(); }
            EpiProj E{(bf16_t*)(ws + OFF_QKV), (bf16_t*)(ws + OFF_ZUV), (float*)(ws + OFF_BA), RS, 0};
#ifndef NO_G3
            pg8::gemm_phase<EpiProj, pg8::StaticOrder>(cx.tid, lds, g, S, E);
#endif
        } else if (kind == K_PREP) {
#pragma unroll 1
#ifndef NO_PREP
            for (int u = cx.bid; u < 1024; u += G) prep_unit(cx, lds, p, u);
#else
            for (int u = cx.bid; u < 0; u += G) {}
#endif
        } else if (kind == K_SCAN) {
#ifndef NO_SCAN
            if (cx.bid >= 128) {
                convert_tiles<false>(cx, lds, p, CT_EARLY, CT_ALL, cx.bid - 128, G - 128);
#pragma unroll 1
                for (int u = cx.bid - 128; u < 1024; u += G - 128) sg_unit(cx, lds, p, u);
            }
            phase_scan(cx, lds, p);
#endif
        } else if (kind == K_OUT) {
#pragma unroll 1
#ifndef NO_OUT
            for (int u = cx.bid; u < 1024; u += G) out_unit(cx, p, 2 * u + (cx.tid >> 8));
#else
            for (int u = cx.bid; u < 0; u += G) {}
#endif
        } else if (kind == K_POOL) {
#pragma unroll 1
#ifndef NO_POOL
            for (int u = cx.bid; u < 512; u += G) pool_unit(cx, lds, p, XB, ssq_in, u);
#else
            for (int u = cx.bid; u < 0; u += G) {}
#endif
        } else {
#ifndef NO_FIN
            phase_final(cx, p, XB, X);
#endif
        }
        if (step < 16) xcd_barrier(xbar);
    }
}

extern "C" void kernel_launch(void* const* d_in, const int* in_sizes, int n_in, void* d_out, int out_size, void* d_ws, size_t ws_size, hipStream_t stream) {
    static int grid_blocks = 0;
    if (grid_blocks == 0) {
        if (n_in != 20 || ws_size < WS_END) { fprintf(stderr, "kernel_launch: need 20 inputs and %zu bytes of workspace (got %d, %zu)\n", (size_t)WS_END, n_in, ws_size); grid_blocks = -1; return; }
        int dev = 0, cus = 0, per_cu = 0;
        (void)hipGetDevice(&dev);
        (void)hipDeviceGetAttribute(&cus, hipDeviceAttributeMultiprocessorCount, dev);
        if (hipFuncSetAttribute((const void*)fwd_megakernel, hipFuncAttributeMaxDynamicSharedMemorySize, LDS_BYTES) != hipSuccess) { fprintf(stderr, "kernel_launch: hipFuncSetAttribute failed\n"); grid_blocks = -1; return; }
        if (hipOccupancyMaxActiveBlocksPerMultiprocessor(&per_cu, (const void*)fwd_megakernel, NTHREADS, LDS_BYTES) != hipSuccess || per_cu < 1) per_cu = 1;
        (void)hipGetLastError();
        grid_blocks = cus * 1;
        if (grid_blocks < 128) { fprintf(stderr, "kernel_launch: needs >= 128 CUs\n"); grid_blocks = -1; return; }
    }
    if (grid_blocks < 0) return;
    Params p{};
    for (int i = 0; i < 20; ++i) p.in[i] = (const float*)d_in[i];
    p.out = (float*)d_out; p.ws = (unsigned char*)d_ws;
    void* args[] = {&p};
    hipError_t e = hipLaunchCooperativeKernel((const void*)fwd_megakernel, dim3(grid_blocks), dim3(NTHREADS), args, LDS_BYTES, stream);
    if (e != hipSuccess) fprintf(stderr, "cooperative launch failed: %s (grid %d)\n", hipGetErrorString(e), grid_blocks);
}
```

```cpp
#include <hip/hip_runtime.h>
#include <hip/hip_cooperative_groups.h>
#include <cstdio>
namespace pg8 {
#define PG8_LAS __attribute__((address_space(3)))
typedef unsigned short bf16_t;
typedef short bf16x8 __attribute__((ext_vector_type(8)));
typedef float f32x4 __attribute__((ext_vector_type(4)));
typedef unsigned u32x4 __attribute__((ext_vector_type(4)));
constexpr int BM = 256, BK = 64, HALF = 128, HTB = HALF * BK * 2  , STAGE_BYTES = 8 * HTB, NXCD = 8, WGM = 8;

__host__ __device__ __forceinline__ int lds_byte(int r, int c) { const int st = (r >> 4) * 2 + (c >> 5), rr = r & 15, cc = c & 31, ob = rr * 64 + cc * 2; return st * 1024 + (ob ^ (((ob >> 9) & 1) << 5)); }
__host__ __device__ __forceinline__ void stage_rc(int b, int& R, int& C) { const int st = b / 1024, sb = b % 1024, swz = sb ^ (((sb >> 9) & 1) << 5); R = (st >> 1) * 16 + swz / 64; C = (st & 1) * 32 + (swz % 64) / 2; }
__host__ __device__ __forceinline__ int perm32(int rho) { const int n = rho >> 4, i = rho & 15; return 8 * (i >> 2) + 4 * n + (i & 3); }

struct Unit { int pm, pn; };
struct Gemm { const bf16_t* A; const bf16_t* Bt; int M, N, K; int lda; size_t a_pn_bytes; };

struct StaticOrder {
    int nM, nN, nwg, G, c;
    __host__ __device__ void init(int M, int N, int G_, int c_) { nM = M / BM; nN = N / BM; nwg = nM * nN; G = G_; c = c_; }
    __host__ __device__ bool next(int i, Unit& u) const {
        const long L = (long)i * G + c; if (L >= nwg) return false;
        int wgid = (int)L; { const int q = nwg / NXCD, r = nwg % NXCD, xcd = wgid % NXCD, off = wgid / NXCD; wgid = (xcd < r ? xcd * (q + 1) : r * (q + 1) + (xcd - r) * q) + off; }
        const int nig = WGM * nN, gid = wgid / nig, fm = gid * WGM, gsz = (nM - fm) < WGM ? (nM - fm) : WGM;
        u.pm = fm + ((wgid % nig) % gsz); u.pn = (wgid % nig) / gsz; return true;
    }
    __device__ __forceinline__ void a_ready(const Unit&) const {}
    __device__ __forceinline__ void done(const Unit&) const {}
};
__device__ __forceinline__ unsigned cvt_pk_bf16(float lo, float hi) { unsigned r; asm volatile("v_cvt_pk_bf16_f32 %0, %1, %2" : "=v"(r) : "v"(lo), "v"(hi)); return r; }
typedef float f32x2 __attribute__((ext_vector_type(2)));
__device__ __forceinline__ f32x2 gelu_pk(f32x2 v) {
    const f32x2 av = __builtin_elementwise_abs(v), d = av * 0.2316418882f + 1.0f;
    f32x2 t; t.x = __builtin_amdgcn_rcpf(d.x); t.y = __builtin_amdgcn_rcpf(d.y);
    f32x2 q = t * 0.5307027145f + (-0.7265760135f); q = q * t + 0.7107068705f; q = q * t + (-0.142248368f); q = q * t + 0.127414796f; q = q * t;
    const f32x2 s = (v * v) * (-0.72134752044f);
    f32x2 e; e.x = __builtin_amdgcn_exp2f(s.x); e.y = __builtin_amdgcn_exp2f(s.y);
    const f32x2 m = v * (q * e), r = v - m;
    f32x2 o; o.x = v.x < 0.f ? m.x : r.x; o.y = v.y < 0.f ? m.y : r.y; return o;
}

template <class Epi, class Sched>
__device__ __forceinline__ void gemm_phase(const int tid, PG8_LAS unsigned char* lds, const Gemm g, const Sched& S, const Epi& E) {
    const int wid = __builtin_amdgcn_readfirstlane(tid >> 6), lane = tid & 63, wr = wid >> 2, wc = wid & 3, fr = lane & 15, fq = lane >> 4;
    const int K = g.K, nt = K / BK;
    unsigned voffA[2], voffB[2];
#pragma unroll
    for (int i = 0; i < 2; ++i) { int R, C; stage_rc(tid * 16 + i * 8192, R, C); const int Rb = Epi::PERM ? ((R & ~31) + perm32(R & 31)) : R;
        voffA[i] = (unsigned)(R * g.lda + C) * 2u; voffB[i] = (unsigned)(Rb * K + C) * 2u; }
    const size_t kstep = (size_t)(BK * 2);
    const size_t hstepA = (size_t)HALF * g.lda * 2, hstepB = (size_t)HALF * K * 2;
    const size_t tstepA = 2 * hstepA, tstepB = 2 * hstepB;
    const unsigned ldsw = (unsigned)wid * 1024u;
    const int aoff = lds_byte(wr * 64 + fr, fq * 8), boff = lds_byte(wc * 32 + fr, fq * 8);
#define PG8_SA(b, h) (((b) * 2 + (h)) * HTB)
#define PG8_SB(b, h) ((4 + (b) * 2 + (h)) * HTB)
#define PG8_STAGE(bufoff, gbase, voff) do { const char* _sb = (const char*)(gbase); asm volatile("" : "+s"(_sb));   \
        _Pragma("unroll") for (int _i = 0; _i < 2; ++_i) \
        __builtin_amdgcn_global_load_lds((const unsigned*)(_sb + (voff)[_i]), (PG8_LAS unsigned*)(lds + (bufoff) + ldsw + _i * 8192), 16, 0, 0); } while (0)
#define PG8_LDA(dst, b, h) do { _Pragma("unroll") for (int m = 0; m < 4; ++m) _Pragma("unroll") for (int k = 0; k < 2; ++k) dst[m][k] = *(const PG8_LAS bf16x8*)(lds + PG8_SA(b, h) + aoff + m * 2048 + k * 1024); } while (0)
#define PG8_LDB(dst, b, h) do { _Pragma("unroll") for (int n = 0; n < 2; ++n) _Pragma("unroll") for (int k = 0; k < 2; ++k) dst[n][k] = *(const PG8_LAS bf16x8*)(lds + PG8_SB(b, h) + boff + n * 2048 + k * 1024); } while (0)
#define PG8_MMA(ai, bj, At, Bt) do { __builtin_amdgcn_s_setprio(1); _Pragma("unroll") for (int m = 0; m < 4; ++m) _Pragma("unroll") for (int n = 0; n < 2; ++n) _Pragma("unroll") for (int k = 0; k < 2; ++k) \
        acc[ai][bj][m][n] = __builtin_amdgcn_mfma_f32_16x16x32_bf16(Bt[n][k], At[m][k], acc[ai][bj][m][n], 0, 0, 0); __builtin_amdgcn_s_setprio(0); } while (0)
#define PG8_WAIT_V(n) asm volatile("s_waitcnt vmcnt(" #n ")" ::: "memory")
#define PG8_WAIT_L(n) asm volatile("s_waitcnt lgkmcnt(" #n ")" ::: "memory")
#define PG8_BAR __builtin_amdgcn_s_barrier()
#define PG8_SCHED __builtin_amdgcn_sched_barrier(0)
    Unit cur, nxt; int ui = 0;
    if (!S.next(0, cur)) return;
    f32x4 acc[2][2][4][2];
#pragma unroll
    for (int a = 0; a < 2; ++a)
#pragma unroll
        for (int b = 0; b < 2; ++b)
#pragma unroll
            for (int m = 0; m < 4; ++m)
#pragma unroll
                for (int n = 0; n < 2; ++n) acc[a][b][m][n] = (f32x4){0.f, 0.f, 0.f, 0.f};
    bf16x8 At[4][2], B0[2][2], B1[2][2];
    const char* cA = (const char*)g.A + (size_t)cur.pm * tstepA + (size_t)cur.pn * g.a_pn_bytes; const char* cB = (const char*)g.Bt + (size_t)cur.pn * tstepB;
    S.a_ready(cur);
    PG8_STAGE(PG8_SB(0, 0), cB, voffB); PG8_STAGE(PG8_SB(0, 1), cB + hstepB, voffB); PG8_STAGE(PG8_SA(0, 0), cA, voffA); PG8_STAGE(PG8_SA(0, 1), cA + hstepA, voffA);
    if (wr == 1) PG8_BAR;
    PG8_WAIT_V(2); PG8_BAR;
    PG8_STAGE(PG8_SB(1, 0), cB + kstep, voffB); PG8_STAGE(PG8_SA(1, 0), cA + kstep, voffA); PG8_STAGE(PG8_SB(1, 1), cB + hstepB + kstep, voffB);
    PG8_WAIT_V(6); PG8_BAR;
    for (;;) {
        const bool has_next = S.next(ui + 1, nxt);
        const char* nA = has_next ? (const char*)g.A + (size_t)nxt.pm * tstepA + (size_t)nxt.pn * g.a_pn_bytes : cA; const char* nB = has_next ? (const char*)g.Bt + (size_t)nxt.pn * tstepB : cB;
        for (int t = 0; t < nt; t += 2) {
            const bool last = (t == nt - 2);
            const char* a1 = cA + (size_t)(t + 1) * kstep;
            const char* a2 = last ? nA : cA + (size_t)(t + 2) * kstep; const char* b2 = last ? nB : cB + (size_t)(t + 2) * kstep;
            const char* a3 = a2 + kstep; const char* b3 = b2 + kstep;
            if (last && has_next) S.a_ready(nxt);
            PG8_LDB(B0, 0, 0); PG8_LDB(B1, 0, 1); PG8_SCHED; PG8_LDA(At, 0, 0); PG8_STAGE(PG8_SA(1, 1), a1 + hstepA, voffA);
            PG8_WAIT_V(8); PG8_WAIT_L(0); PG8_BAR; PG8_MMA(0, 0, At, B0); PG8_MMA(0, 1, At, B1); PG8_BAR; PG8_SCHED;
            PG8_LDA(At, 0, 1); PG8_STAGE(PG8_SB(0, 0), b2, voffB); PG8_STAGE(PG8_SB(0, 1), b2 + hstepB, voffB); PG8_STAGE(PG8_SA(0, 0), a2, voffA);
            PG8_WAIT_V(8); PG8_WAIT_L(0); PG8_BAR; PG8_MMA(1, 0, At, B0); PG8_MMA(1, 1, At, B1); PG8_BAR; PG8_SCHED;
            PG8_LDB(B0, 1, 0); PG8_LDB(B1, 1, 1); PG8_SCHED; PG8_LDA(At, 1, 0); PG8_STAGE(PG8_SA(0, 1), a2 + hstepA, voffA);
            PG8_WAIT_V(8); PG8_WAIT_L(0); PG8_BAR; PG8_MMA(0, 0, At, B0); PG8_MMA(0, 1, At, B1); PG8_BAR; PG8_SCHED;
            PG8_LDA(At, 1, 1); PG8_STAGE(PG8_SB(1, 0), b3, voffB); PG8_STAGE(PG8_SB(1, 1), b3 + hstepB, voffB); PG8_STAGE(PG8_SA(1, 0), a3, voffA);
            PG8_WAIT_V(8); PG8_WAIT_L(0); PG8_BAR; PG8_MMA(1, 0, At, B0); PG8_MMA(1, 1, At, B1); PG8_BAR; PG8_SCHED;
        }
        if (wr == 0) PG8_BAR;
        if constexpr (!Epi::AFTER_DRAIN) { E(acc, cur, wr, wc, fr, fq); S.done(cur); }
        if (!has_next) break;
#pragma unroll
        for (int a = 0; a < 2; ++a)
#pragma unroll
            for (int b = 0; b < 2; ++b)
#pragma unroll
                for (int m = 0; m < 4; ++m)
#pragma unroll
                    for (int n = 0; n < 2; ++n) acc[a][b][m][n] = (f32x4){0.f, 0.f, 0.f, 0.f};
        cur = nxt; cA = nA; cB = nB; ++ui;
        if (wr == 1) PG8_BAR;
    }
    PG8_WAIT_V(0);
    PG8_BAR;
    if constexpr (Epi::AFTER_DRAIN) { E.fused(acc, cur, wr, wc, fr, fq, lds, wid, lane); S.done(cur); }
#undef PG8_SA
#undef PG8_SB
#undef PG8_STAGE
#undef PG8_LDA
#undef PG8_LDB
#undef PG8_MMA
#undef PG8_WAIT_V
#undef PG8_WAIT_L
#undef PG8_BAR
#undef PG8_SCHED
}
}


namespace cg = cooperative_groups;
using pg8::bf16_t; using pg8::bf16x8; using pg8::f32x4; using pg8::u32x4; using pg8::f32x2;
#define LAS __attribute__((address_space(3)))
#define GAS __attribute__((address_space(1)))
typedef unsigned u32x2 __attribute__((ext_vector_type(2)));

constexpr int MTOK = 32768, DM = 1024, FF = 2816, NFF = 5632, SEQ = 8192, NPROJ = 3328;
constexpr int LDS_BYTES = 144 * 1024;
constexpr int NTHREADS = 512;

constexpr size_t SZ_WFFIN1 = (size_t)NFF * DM * 2, SZ_WFFOUT1 = (size_t)DM * FF * 2;
constexpr size_t OFF_WFFIN = 0;
constexpr size_t OFF_WFFOUT = OFF_WFFIN + 4 * SZ_WFFIN1;
constexpr size_t OFF_WABIN = OFF_WFFOUT + 4 * SZ_WFFOUT1;
constexpr size_t OFF_WABOUT = OFF_WABIN + (size_t)NPROJ * DM * 2;
constexpr size_t OFF_WPOOL = OFF_WABOUT + (size_t)DM * DM * 2;
constexpr size_t OFF_SGW = OFF_WPOOL + (size_t)4 * 256 * 256 * 2;
constexpr size_t OFF_XB = OFF_SGW + (size_t)4 * 128 * 128 * 2;
constexpr size_t SZ_SSQ1 = (size_t)MTOK * 16 * 4;
constexpr size_t OFF_SSQ = OFF_XB + (size_t)MTOK * DM * 2;
constexpr size_t OFF_EG = OFF_SSQ + 2 * SZ_SSQ1;
constexpr size_t OFF_TAB = OFF_EG + 8192;
constexpr size_t OFF_SCL = OFF_TAB + 256;
constexpr size_t OFF_BAR = OFF_SCL + 8192;
constexpr size_t OFF_BIG = OFF_BAR + 16384;
constexpr size_t OFF_HB = OFF_BIG;
constexpr size_t OFF_QKV = OFF_BIG;
constexpr size_t OFF_STT = OFF_BIG;
constexpr size_t OFF_VNT = OFF_BIG + (size_t)2048 * 16384 * 2;
constexpr size_t OFF_ZUV = OFF_BIG + (size_t)MTOK * 1536 * 2;
constexpr size_t OFF_BA = OFF_ZUV + (size_t)MTOK * 1536 * 2;
constexpr size_t OFF_PW = OFF_BA + (size_t)MTOK * 8 * 4;
constexpr size_t OFF_PUT = OFF_PW + (size_t)2048 * 8192 * 2;
constexpr size_t OFF_PKT = OFF_PUT + (size_t)2048 * 8192 * 2;
constexpr size_t OFF_PQD = OFF_PKT + (size_t)2048 * 8192 * 2;
constexpr size_t OFF_PATT = OFF_PQD + (size_t)2048 * 8192 * 2;
constexpr size_t OFF_PO = OFF_BIG;
constexpr size_t WS_END = OFF_PATT + (size_t)2048 * 4096 * 2;

struct Params { const float* in[20]; float* out; unsigned char* ws; };
struct Ctx { int tid, bid, G; unsigned char* ws; const float* const* in; };

__device__ __forceinline__ float bf2f(unsigned short b) { return __uint_as_float(((unsigned)b) << 16); }
typedef __bf16 bf16x2v __attribute__((ext_vector_type(2)));
__device__ __forceinline__ unsigned pk2(float lo, float hi) { const f32x2 v = {lo, hi}; const bf16x2v b = __builtin_convertvector(v, bf16x2v); return __builtin_bit_cast(unsigned, b); }
__device__ __forceinline__ unsigned short f2bf(float f) { return (unsigned short)pk2(f, 0.f); }
#define LDS_BARRIER() do { asm volatile("s_waitcnt lgkmcnt(0)" ::: "memory"); __builtin_amdgcn_s_barrier(); asm volatile("" ::: "memory"); } while (0)
__device__ __forceinline__ float bflo(unsigned w) { return __uint_as_float(w << 16); }
__device__ __forceinline__ float bfhi(unsigned w) { return __uint_as_float(w & 0xffff0000u); }
__device__ __forceinline__ float silu_f(float x) { return x * __builtin_amdgcn_rcpf(1.0f + __builtin_amdgcn_exp2f(x * -1.4426950408889634f)); }
__device__ __forceinline__ float rstd_of(const float* ssq, size_t row) {
    const f32x4* s = (const f32x4*)(ssq + row * 16);
    const f32x4 a = s[0], b = s[1], c = s[2], d = s[3];
    const float t = ((a[0] + a[1]) + (a[2] + a[3])) + ((b[0] + b[1]) + (b[2] + b[3])) + ((c[0] + c[1]) + (c[2] + c[3])) + ((d[0] + d[1]) + (d[2] + d[3]));
    return rsqrtf(t * (1.0f / 1024.0f) + 1e-6f);
}
__device__ __forceinline__ float rstd_coop(const float* ssq, size_t row, int fq) {
    const f32x4 a = *(const f32x4*)(ssq + row * 16 + fq * 4);
    float t = (a[0] + a[1]) + (a[2] + a[3]);
    t += __shfl_xor(t, 16); t += __shfl_xor(t, 32);
    return rsqrtf(t * (1.0f / 1024.0f) + 1e-6f);
}
__device__ __forceinline__ float sel4(const f32x4 v, int r) { return r == 0 ? v[0] : (r == 1 ? v[1] : (r == 2 ? v[2] : v[3])); }
#define MFMA16(a, b, c) __builtin_amdgcn_mfma_f32_16x16x32_bf16((a), (b), (c), 0, 0, 0)


#define XB_READY    64
#define XB_MAGIC    0x5EEDBA55u
#define XB_TMO      128
#define XB_XCNT(j)  (256  + 64 * (j))
#define XB_XSUB(j)  (1280 + 64 * (j))
#define XB_XGEN(j)  (2304 + 64 * (j))
#define XB_TOP      3328
#define XB_TOPGEN   3392
#define XCD_BAR_WORDS 3456
#define XB_SPIN_CAP (1u << 18)
__device__ __forceinline__ unsigned xb_ld(unsigned* p)              { return __hip_atomic_load(p, __ATOMIC_RELAXED, __HIP_MEMORY_SCOPE_AGENT); }
__device__ __forceinline__ unsigned xb_add(unsigned* p, unsigned v) { return __hip_atomic_fetch_add(p, v, __ATOMIC_RELAXED, __HIP_MEMORY_SCOPE_AGENT); }
__device__ __forceinline__ unsigned xb_xcc_id() { return (unsigned)__builtin_amdgcn_s_getreg((3 << 11) | 20) & 0xFu; }
#define XB_SPIN(cond, bar) do { unsigned _sp = 0; while (cond) { __builtin_amdgcn_s_sleep(1); \
    if ((++_sp & 255u) == 0u) { if (xb_ld(&(bar)[XB_TMO])) break; if (_sp > XB_SPIN_CAP) { atomicAdd(&(bar)[XB_TMO], 1u); break; } } } } while (0)
struct XcdBarrier { unsigned* bar; unsigned x; volatile LAS unsigned* st; };
__device__ __forceinline__ XcdBarrier xcd_barrier_post(unsigned* bar, volatile LAS unsigned* st) {
    XcdBarrier b; b.bar = bar; b.x = xb_xcc_id(); b.st = st;
    if (threadIdx.x == 0) (void)xb_add(&bar[XB_XCNT(b.x)], 1u);
    return b;
}
__device__ __forceinline__ void xcd_barrier_complete(unsigned* bar, unsigned x, unsigned& nloc, unsigned& nx) {
    const unsigned G = gridDim.x * gridDim.y * gridDim.z;
    unsigned sum, cnt, mine, sp = 0u;
    for (;;) {
        sum = 0u; cnt = 0u; mine = 0u;
#pragma unroll
        for (unsigned j = 0; j < 16; ++j) { const unsigned c = xb_ld(&bar[XB_XCNT(j)]); sum += c; cnt += (c > 0u) ? 1u : 0u; mine = (j == x) ? c : mine; }
        if (sum == G) break;
        __builtin_amdgcn_s_sleep(1);
        if ((++sp & 255u) == 0u) { if (xb_ld(&bar[XB_TMO])) break; if (sp > XB_SPIN_CAP) { atomicAdd(&bar[XB_TMO], 1u); break; } }
    }
    nloc = mine > 0u ? mine : 1u; nx = cnt > 0u ? cnt : 1u;
}
__device__ __forceinline__ void xcd_barrier(const XcdBarrier& b) {
    asm volatile("s_waitcnt vmcnt(0)" ::: "memory");
    __syncthreads();
    if (threadIdx.x == 0) {
        unsigned* bar = b.bar;
        __builtin_amdgcn_s_waitcnt(0);
        unsigned nloc = b.st[0], nx = b.st[1];
        if (nloc == 0u) { xcd_barrier_complete(bar, b.x, nloc, nx); b.st[0] = nloc; b.st[1] = nx; }
        const unsigned old = xb_add(&bar[XB_XSUB(b.x)], 1u);
        const unsigned gen = old / nloc;
        if (old + 1u == (gen + 1u) * nloc) {
            __builtin_amdgcn_fence(__ATOMIC_RELEASE, "agent");
            asm volatile("s_waitcnt vmcnt(0)" ::: "memory");
            const unsigned og = xb_add(&bar[XB_TOP], 1u);
            const unsigned tg = og / nx;
            if (og + 1u == (tg + 1u) * nx) xb_add(&bar[XB_TOPGEN], 1u);
            else XB_SPIN(xb_ld(&bar[XB_TOPGEN]) == tg, bar);
            __builtin_amdgcn_fence(__ATOMIC_ACQUIRE, "agent");
            xb_add(&bar[XB_XGEN(b.x)], 1u);
            asm volatile("s_waitcnt vmcnt(0)" ::: "memory");
        } else {
            XB_SPIN(xb_ld(&bar[XB_XGEN(b.x)]) == gen, bar);
            __builtin_amdgcn_fence(__ATOMIC_ACQUIRE, "agent");
            asm volatile("s_waitcnt vmcnt(0)" ::: "memory");
        }
    }
    __syncthreads();
}

struct EpiSwiglu {
    static constexpr bool PERM = true, AFTER_DRAIN = false;
    bf16_t* H; const LAS float* RS; mutable int ui;
    __device__ __forceinline__ void operator()(const f32x4 (&acc)[2][2][4][2], const pg8::Unit& u, int wr, int wc, int fr, int fq) const {
        const int row0 = u.pm * 256 + wr * 64 + fr, col0 = u.pn * 128 + wc * 32 + 8 * fq;
        const LAS float* rsu = RS + ui * 256 + wr * 64 + fr; ++ui;
#pragma unroll
        for (int ai = 0; ai < 2; ++ai)
#pragma unroll
            for (int m = 0; m < 4; ++m) {
                const size_t row = (size_t)(row0 + ai * 128 + m * 16);
                const float rs = rsu[ai * 128 + m * 16];
                float hv[8];
#pragma unroll
                for (int n = 0; n < 2; ++n)
#pragma unroll
                    for (int j = 0; j < 4; ++j) { const float g = acc[ai][0][m][n][j] * rs, up = acc[ai][1][m][n][j] * rs; hv[n * 4 + j] = silu_f(g) * up; }
                u32x4 w; w.x = pk2(hv[0], hv[1]); w.y = pk2(hv[2], hv[3]); w.z = pk2(hv[4], hv[5]); w.w = pk2(hv[6], hv[7]);
                *(GAS u32x4*)(H + row * FF + col0) = w;
            }
    }
};
struct EpiResid {
    static constexpr bool PERM = true, AFTER_DRAIN = false;
    bf16_t* XB; float* ssq_out; const float* colscale;
    __device__ __forceinline__ void operator()(const f32x4 (&acc)[2][2][4][2], const pg8::Unit& u, int wr, int wc, int fr, int fq) const {
        const int row0 = u.pm * 256 + wr * 64 + fr, col0 = u.pn * 256 + wc * 32 + 8 * fq;
        bf16_t* xb = XB + (size_t)row0 * DM + col0;
        u32x4 xin[2][4][2];
#pragma unroll
        for (int ai = 0; ai < 2; ++ai)
#pragma unroll
            for (int m = 0; m < 4; ++m)
#pragma unroll
                for (int bj = 0; bj < 2; ++bj) xin[ai][m][bj] = *(const GAS u32x4*)(xb + (size_t)(ai * 128 + m * 16) * DM + bj * 128);
        f32x4 cs[2][2];
#pragma unroll
        for (int bj = 0; bj < 2; ++bj)
#pragma unroll
            for (int n = 0; n < 2; ++n) cs[bj][n] = *(const GAS f32x4*)(colscale + col0 + bj * 128 + 4 * n);
#pragma unroll
        for (int ai = 0; ai < 2; ++ai)
#pragma unroll
            for (int m = 0; m < 4; ++m) {
                float ss = 0.f;
#pragma unroll
                for (int bj = 0; bj < 2; ++bj) {
                    const u32x4 x = xin[ai][m][bj];
                    const f32x4 v0 = acc[ai][bj][m][0] * cs[bj][0], v1 = acc[ai][bj][m][1] * cs[bj][1];
                    const float o0 = bflo(x.x) + v0[0], o1 = bfhi(x.x) + v0[1], o2 = bflo(x.y) + v0[2], o3 = bfhi(x.y) + v0[3];
                    const float o4 = bflo(x.z) + v1[0], o5 = bfhi(x.z) + v1[1], o6 = bflo(x.w) + v1[2], o7 = bfhi(x.w) + v1[3];
                    u32x4 w; w.x = pk2(o0, o1); w.y = pk2(o2, o3); w.z = pk2(o4, o5); w.w = pk2(o6, o7);
                    *(GAS u32x4*)(xb + (size_t)(ai * 128 + m * 16) * DM + bj * 128) = w;
                    ss += ((o0 * o0 + o1 * o1) + (o2 * o2 + o3 * o3)) + ((o4 * o4 + o5 * o5) + (o6 * o6 + o7 * o7));
                }
                ss += __shfl_xor(ss, 16); ss += __shfl_xor(ss, 32);
                if (fq == 0) *(GAS float*)(ssq_out + (size_t)(row0 + ai * 128 + m * 16) * 16 + u.pn * 4 + wc) = ss;
            }
    }
};
struct EpiProj {
    static constexpr bool PERM = true, AFTER_DRAIN = false;
    bf16_t* QKV; bf16_t* ZUV; float* BA; const LAS float* RS; mutable int ui;
    __device__ __forceinline__ void operator()(const f32x4 (&acc)[2][2][4][2], const pg8::Unit& u, int wr, int wc, int fr, int fq) const {
        const int row0 = u.pm * 256 + wr * 64 + fr, colw = wc * 32 + 8 * fq;
        const LAS float* rsu = RS + ui * 256 + wr * 64 + fr; ++ui;
        const int pn = u.pn;
#pragma unroll
        for (int ai = 0; ai < 2; ++ai)
#pragma unroll
            for (int m = 0; m < 4; ++m) {
                const size_t row = (size_t)(row0 + ai * 128 + m * 16);
                const float rs = rsu[ai * 128 + m * 16];
#pragma unroll
                for (int bj = 0; bj < 2; ++bj) {
                    f32x4 v0 = acc[ai][bj][m][0] * rs, v1 = acc[ai][bj][m][1] * rs;
                    const int c = pn * 256 + bj * 128 + colw;
                    if (pn < 6) {
                        u32x4 w; w.x = pk2(v0[0], v0[1]); w.y = pk2(v0[2], v0[3]); w.z = pk2(v1[0], v1[1]); w.w = pk2(v1[2], v1[3]);
                        *(GAS u32x4*)(QKV + row * 1536 + c) = w;
                    } else if (pn < 12) {
                        if (pn < 8) {
#pragma unroll
                            for (int j = 0; j < 4; ++j) { v0[j] = silu_f(v0[j]); v1[j] = silu_f(v1[j]); }
                        } else {
                            const f32x2 a = pg8::gelu_pk((f32x2){v0[0], v0[1]}), b = pg8::gelu_pk((f32x2){v0[2], v0[3]}), cc = pg8::gelu_pk((f32x2){v1[0], v1[1]}), d = pg8::gelu_pk((f32x2){v1[2], v1[3]});
                            v0 = (f32x4){a.x, a.y, b.x, b.y}; v1 = (f32x4){cc.x, cc.y, d.x, d.y};
                        }
                        u32x4 w; w.x = pk2(v0[0], v0[1]); w.y = pk2(v0[2], v0[3]); w.z = pk2(v1[0], v1[1]); w.w = pk2(v1[2], v1[3]);
                        *(GAS u32x4*)(ZUV + row * 1536 + (c - 1536)) = w;
                    } else {
                        if (bj == 0 && colw == 0) { *(GAS f32x4*)(BA + row * 8) = v0; *(GAS f32x4*)(BA + row * 8 + 4) = v1; }
                    }
                }
            }
    }
};

struct MapId { __device__ __forceinline__ int operator()(int n) const { return n; } };
struct MapFfn { __device__ __forceinline__ int operator()(int n) const { const int pn = n >> 8, r = n & 255; return r < 128 ? 128 * pn + r : FF + 128 * pn + (r - 128); } };
struct MapAb { __device__ __forceinline__ int operator()(int n) const { return n < 2048 ? n : (n < 3072 ? n + 8 : (n < 3080 ? n - 1024 : -1)); } };

constexpr int CT_EARLY = 1472, CT_ALL = 4800;
struct TileDesc { const float* src; const float* gain; bf16_t* dst; int ldsrc, K, k0, n0, mapk; };
__device__ __forceinline__ int tile_map(int mapk, int n) { return mapk == 0 ? n : (mapk == 1 ? MapFfn()(n) : MapAb()(n)); }
template <bool EARLY>
__device__ __forceinline__ TileDesc tile_decode(const Ctx& cx, const Params& p, int idx) {
#define INP(i) (EARLY ? p.in[i] : cx.in[i])
    unsigned char* ws = cx.ws; TileDesc d;
    if (idx < 704 || (idx >= 1472 && idx < 3584)) {
        const int i2 = idx < 704 ? idx : idx - 1472, w = idx < 704 ? 0 : 1 + i2 / 704, t = i2 % 704, l = w >> 1, which = w & 1;
        d.src = (which ? INP(6) : INP(2)) + (size_t)l * DM * NFF; d.gain = (which ? INP(5) : INP(1)) + l * DM;
        d.dst = (bf16_t*)(ws + OFF_WFFIN + (size_t)w * SZ_WFFIN1); d.ldsrc = NFF; d.K = DM; d.k0 = (t & 15) * 64; d.n0 = (t >> 4) * 128; d.mapk = 1;
    } else if (idx < 1056 || (idx >= 3584 && idx < 4640)) {
        const int i2 = idx < 1056 ? idx - 704 : idx - 3584, w = idx < 1056 ? 0 : 1 + i2 / 352, t = i2 % 352, l = w >> 1, which = w & 1;
        d.src = (which ? INP(7) : INP(3)) + (size_t)l * FF * DM; d.gain = nullptr;
        d.dst = (bf16_t*)(ws + OFF_WFFOUT + (size_t)w * SZ_WFFOUT1); d.ldsrc = DM; d.K = FF; d.k0 = (t % 44) * 64; d.n0 = (t / 44) * 128; d.mapk = 0;
    } else if (idx < 1472) {
        const int t = idx - 1056;
        d.src = INP(8); d.gain = INP(4); d.dst = (bf16_t*)(ws + OFF_WABIN); d.ldsrc = 3080; d.K = DM; d.k0 = (t & 15) * 64; d.n0 = (t >> 4) * 128; d.mapk = 2;
    } else if (idx < 4768) {
        const int t = idx - 4640;
        d.src = INP(16); d.gain = nullptr; d.dst = (bf16_t*)(ws + OFF_WABOUT); d.ldsrc = DM; d.K = DM; d.k0 = (t & 15) * 64; d.n0 = (t >> 4) * 128; d.mapk = 0;
    } else {
        const int i2 = idx - 4768, g = i2 >> 3, t = i2 & 7;
        d.src = INP(17) + (size_t)g * 65536; d.gain = nullptr; d.dst = (bf16_t*)(ws + OFF_WPOOL) + (size_t)g * 65536; d.ldsrc = 256; d.K = 256; d.k0 = (t & 3) * 64; d.n0 = (t >> 2) * 128; d.mapk = 0;
    }
#undef INP
    return d;
}
__device__ __forceinline__ void tile_load(const Ctx& cx, const TileDesc& d, float (&v)[16], float& g0, float& g1) {
    const int j = cx.tid & 127, i0 = cx.tid >> 7; const int col = tile_map(d.mapk, d.n0 + j);
    g0 = 1.f; g1 = 1.f; if (d.gain) { const int kk2 = (cx.tid & 31) * 2; const GAS float* gp = (const GAS float*)d.gain + d.k0 + kk2; g0 = gp[0]; g1 = gp[1]; }
    const GAS float* sp = (const GAS float*)d.src + (size_t)(d.k0 + i0) * d.ldsrc + (col >= 0 ? col : 0);
#pragma unroll
    for (int ii = 0; ii < 16; ++ii) { v[ii] = 0.f; if (col >= 0) v[ii] = sp[(size_t)(4 * ii) * d.ldsrc]; }
}
__device__ __forceinline__ void tile_store(const Ctx& cx, LAS float* tile, const TileDesc& d, const float (&v)[16], const float g0, const float g1) {
    const int tid = cx.tid;
    { const int j = tid & 127, i0 = tid >> 7;
#pragma unroll
      for (int ii = 0; ii < 16; ++ii) tile[(i0 + 4 * ii) * 129 + j] = v[ii]; }
    LDS_BARRIER();
    { const int kk2 = (tid & 31) * 2, jj0 = tid >> 5;
#pragma unroll
      for (int q = 0; q < 8; ++q) { const int n = jj0 + 16 * q; const unsigned w = pk2(tile[kk2 * 129 + n] * g0, tile[(kk2 + 1) * 129 + n] * g1); *(unsigned*)(d.dst + (size_t)(d.n0 + n) * d.K + d.k0 + kk2) = w; } }
    LDS_BARRIER();
}
template <bool EARLY>
__device__ __forceinline__ void convert_tiles(const Ctx& cx, LAS unsigned char* lds, const Params& p, int first, int last, int wk, int nwk) {
    LAS float* tile = (LAS float*)lds;
    int idx = first + wk;
    if (idx >= last) return;
    TileDesc d = tile_decode<EARLY>(cx, p, idx);
    float v[16], g0, g1; tile_load(cx, d, v, g0, g1);
#pragma unroll 1
    for (;;) {
        const int nidx = idx + nwk; const bool more = nidx < last;
        TileDesc dn = d; float vn[16], gn0 = 1.f, gn1 = 1.f;
        if (more) { dn = tile_decode<EARLY>(cx, p, nidx); tile_load(cx, dn, vn, gn0, gn1); }
        else {
#pragma unroll
            for (int ii = 0; ii < 16; ++ii) vn[ii] = 0.f;
        }
        tile_store(cx, tile, d, v, g0, g1);
        if (!more) break;
        d = dn; idx = nidx; g0 = gn0; g1 = gn1;
#pragma unroll
        for (int ii = 0; ii < 16; ++ii) v[ii] = vn[ii];
    }
}

__device__ __forceinline__ void phase_prologue(const Ctx& cx, LAS unsigned char* lds, const Params& p) {
    unsigned char* ws = cx.ws;
    convert_tiles<true>(cx, lds, p, 0, CT_EARLY, cx.bid, cx.G);
    if (cx.bid == 0 && cx.tid == 0) { const float** tab = (const float**)(ws + OFF_TAB);
#pragma unroll
        for (int i = 0; i < 20; ++i) tab[i] = p.in[i]; }
    if (cx.bid == 0) { float* scl = (float*)(ws + OFF_SCL); for (int i = cx.tid; i < 2048; i += NTHREADS) scl[i] = i < 1024 ? 0.5f : 1.0f; }
    { bf16_t* sgw = (bf16_t*)(ws + OFF_SGW); const float* src = p.in[14];
      for (int i = cx.bid * NTHREADS + cx.tid; i < 4 * 128 * 128; i += cx.G * NTHREADS) { const int s = i & 127, t = (i >> 7) & 127; sgw[i] = (s <= t) ? f2bf(src[i]) : (unsigned short)0; } }
    { const int wave = cx.tid >> 6, lane = cx.tid & 63; const float* x = p.in[0]; bf16_t* xb = (bf16_t*)(ws + OFF_XB); float* ssq = (float*)(ws + OFF_SSQ);
      for (int row = (cx.bid * 8 + wave) * 2; row < MTOK; row += cx.G * 16) {
          const f32x4* src = (const f32x4*)(x + (size_t)row * DM); f32x4 v[8];
#pragma unroll
          for (int q = 0; q < 8; ++q) v[q] = src[lane + 64 * q];
#pragma unroll
          for (int rr = 0; rr < 2; ++rr) {
              float ss = 0.f;
#pragma unroll
              for (int q = 0; q < 4; ++q) { const f32x4 t = v[rr * 4 + q]; ss += (t[0] * t[0] + t[1] * t[1]) + (t[2] * t[2] + t[3] * t[3]);
                  u32x2 w; w.x = pk2(t[0], t[1]); w.y = pk2(t[2], t[3]); *(u32x2*)(xb + (size_t)(row + rr) * DM + (lane + 64 * q) * 4) = w; }
              ss += __shfl_xor(ss, 1); ss += __shfl_xor(ss, 2);
              if ((lane & 3) == 0) ssq[(size_t)(row + rr) * 16 + (lane >> 2)] = ss;
          }
      } }
}

constexpr int PREP_HALF = 54272;
__device__ __forceinline__ void prep_unit(const Ctx& cx, LAS unsigned char* lds, const Params& p, int unit) {
    const int tid = cx.tid, half = tid >> 8, tt = tid & 255, lane = tid & 63, wl = (tid >> 6) & 3, fr = lane & 15, fq = lane >> 4;
    const int hp = unit & 1, n = (unit >> 1) & 127, b = unit >> 8;
    const int h = hp * 2 + half;
    const int uid = (b * 4 + h) * 128 + n;
    const size_t rowbase = (size_t)b * SEQ; const int t0 = n * 64;
    unsigned char* ws = cx.ws;
    LAS unsigned char* L = lds + half * PREP_HALF;
    LAS bf16_t* KB = (LAS bf16_t*)L; LAS bf16_t* QB = (LAS bf16_t*)(L + 17408); LAS float* LF = (LAS float*)(L + 34816);
    LAS float* GC = (LAS float*)(L + 52224); LAS float* BETA = GC + 64; LAS float* RK = GC + 128; LAS float* RQ = GC + 192;
    LAS float* F1 = GC + 256; LAS float* F2 = GC + 320; LAS float* F3 = GC + 384;
    const bf16_t* QKV = (const bf16_t*)(ws + OFF_QKV);
    const float* BA = (const float*)(ws + OFF_BA);
    const float* convw = cx.in[9];
    if (tt < 64) {
        const size_t row = rowbase + t0 + tt;
        const float bv = BA[row * 8 + h], av = BA[row * 8 + 4 + h];
        const float beta = 1.0f / (1.0f + expf(-bv));
        const float A = expf(cx.in[10][h]); const float xx = av + cx.in[11][h];
        const float sp = fmaxf(xx, 0.f) + log1pf(expf(-fabsf(xx)));
        float g = -A * sp;
#pragma unroll
        for (int off = 1; off < 64; off <<= 1) { const float o = __shfl_up(g, off); if (lane >= off) g += o; }
        GC[tt] = g; BETA[tt] = beta;
        if (tt == 63) ((float*)(ws + OFF_EG))[uid] = expf(g);
    }
    LAS bf16_t* RAW = (LAS bf16_t*)L;
    {
        const int rr = tt / 48, seg = tt - rr * 48, w3 = seg >> 4, c8 = (seg & 15) * 8;
        const bf16_t* gp = QKV + ((long)rowbase + t0 - 3 + rr) * 1536 + w3 * 512 + h * 128 + c8;
        LAS bf16_t* lp = RAW + rr * 384 + w3 * 128 + c8;
#pragma unroll
        for (int hb = 0; hb < 1; ++hb) {
            u32x4 x[14];
#pragma unroll
            for (int k = 0; k < 14; ++k) {
                const int kk = hb * 14 + k, r = rr + 5 * kk;
                x[k] = (u32x4){0u, 0u, 0u, 0u};
                if (rr < 5 && r < 67 && (n > 0 || r >= 3)) x[k] = *(const u32x4*)(gp + (long)kk * 5 * 1536);
            }
#pragma unroll
            for (int k = 0; k < 14; ++k) {
                const int kk = hb * 14 + k, r = rr + 5 * kk;
                if (rr < 5 && r < 67) *(LAS u32x4*)(lp + kk * 5 * 384) = x[k];
            }
            asm volatile("" ::: "memory");
        }
    }
    LDS_BARRIER();
    const int which = (wl & 1) ^ half, col = (wl >> 1) * 64 + lane;
    float val[64], qv[32];
    {
        const int srccol = (which ? 512 : 1024) + h * 128 + col;
        const float c0 = convw[srccol], c1 = convw[1536 + srccol], c2 = convw[2 * 1536 + srccol], c3 = convw[3 * 1536 + srccol];
        const LAS bf16_t* src = RAW + 3 * 384 + (which ? 128 : 256) + col;
        float xm3 = bf2f(src[-3 * 384]), xm2 = bf2f(src[-2 * 384]), xm1 = bf2f(src[-1 * 384]);
#pragma unroll
        for (int i16 = 0; i16 < 4; ++i16) {
#pragma unroll
            for (int e = 0; e < 16; ++e) { const int i = i16 * 16 + e; const float xi = bf2f(src[i * 384]); const float y = c0 * xm3 + c1 * xm2 + c2 * xm1 + c3 * xi; val[i] = silu_f(y); xm3 = xm2; xm2 = xm1; xm1 = xi; }
            asm volatile("" ::: "memory");
        }
    }
    const int qt0 = which * 32;
    {
        const int srccol = h * 128 + col;
        const float c0 = convw[srccol], c1 = convw[1536 + srccol], c2 = convw[2 * 1536 + srccol], c3 = convw[3 * 1536 + srccol];
        const LAS bf16_t* src = RAW + (3 + qt0) * 384 + col;
        float xm3 = bf2f(src[-3 * 384]), xm2 = bf2f(src[-2 * 384]), xm1 = bf2f(src[-1 * 384]);
#pragma unroll
        for (int i16 = 0; i16 < 2; ++i16) {
#pragma unroll
            for (int e = 0; e < 16; ++e) { const int i = i16 * 16 + e; const float xi = bf2f(src[i * 384]); const float y = c0 * xm3 + c1 * xm2 + c2 * xm1 + c3 * xi; qv[i] = silu_f(y); xm3 = xm2; xm2 = xm1; xm1 = xi; }
            asm volatile("" ::: "memory");
        }
    }
    LDS_BARRIER();
#pragma unroll
    for (int i = 0; i < 32; ++i) QB[(qt0 + i) * 136 + col] = f2bf(qv[i]);
    if (which) {
#pragma unroll
        for (int i = 0; i < 64; ++i) KB[i * 136 + col] = f2bf(val[i]);
    }
    LDS_BARRIER();
    const int r0 = 16 * wl;
    f32x4 kk[4], qk[4];
    {
        bf16x8 ak[4], aq[4];
#pragma unroll
        for (int ks = 0; ks < 4; ++ks) { ak[ks] = *(const LAS bf16x8*)(KB + (r0 + fr) * 136 + ks * 32 + fq * 8); aq[ks] = *(const LAS bf16x8*)(QB + (r0 + fr) * 136 + ks * 32 + fq * 8); }
        f32x4 kd = {0.f, 0.f, 0.f, 0.f}, qd = {0.f, 0.f, 0.f, 0.f};
#pragma unroll
        for (int ks = 0; ks < 4; ++ks) { kd = MFMA16(ak[ks], ak[ks], kd); qd = MFMA16(aq[ks], aq[ks], qd); }
#pragma unroll
        for (int ct = 0; ct < 4; ++ct) {
            kk[ct] = (f32x4){0.f, 0.f, 0.f, 0.f}; qk[ct] = (f32x4){0.f, 0.f, 0.f, 0.f};
            if (ct <= wl) {
                bf16x8 bk[4];
#pragma unroll
                for (int ks = 0; ks < 4; ++ks) bk[ks] = *(const LAS bf16x8*)(KB + (16 * ct + fr) * 136 + ks * 32 + fq * 8);
                asm volatile("" ::: "memory");
#pragma unroll
                for (int ks = 0; ks < 4; ++ks) { kk[ct] = MFMA16(ak[ks], bk[ks], kk[ct]); qk[ct] = MFMA16(aq[ks], bk[ks], qk[ct]); }
            }
        }
        const float dk = sel4(kd, fr & 3), dq = sel4(qd, fr & 3);
        if ((fr >> 2) == fq) { RK[r0 + fr] = rsqrtf(dk + 1e-6f); RQ[r0 + fr] = rsqrtf(dq + 1e-6f) * 0.08838834764831845f; }
    }
    LDS_BARRIER();
    LAS bf16_t* AT = KB;
    if (tt < 64) { const float g = GC[tt], eg = __expf(g); F1[tt] = RK[tt] * BETA[tt] * eg; F2[tt] = RK[tt] * __expf(GC[63] - g); F3[tt] = RQ[tt] * eg; }
    {
#pragma unroll
        for (int ct = 0; ct < 4; ++ct)
#pragma unroll
            for (int r = 0; r < 4; ++r) {
                const int c = r0 + fq * 4 + r, s = 16 * ct + fr;
                const float dec = __expf(fminf(GC[c] - GC[s], 0.f));
                const float lv = (c > s) ? kk[ct][r] * RK[c] * RK[s] * BETA[c] * dec : 0.f;
                LF[c * 68 + s] = lv;
                const float av = (c >= s) ? qk[ct][r] * RQ[c] * RK[s] * dec : 0.f;
                AT[c * 72 + s] = f2bf(av);
            }
    }
    LDS_BARRIER();
    {
        if (which) {
            bf16_t* KT = (bf16_t*)(ws + OFF_PKT) + (size_t)uid * 8192 + col * 64;
#pragma unroll
            for (int i8 = 0; i8 < 8; ++i8) {
                const f32x4 f2a = *(const LAS f32x4*)(F2 + i8 * 8), f2b = *(const LAS f32x4*)(F2 + i8 * 8 + 4), f1a = *(const LAS f32x4*)(F1 + i8 * 8), f1b = *(const LAS f32x4*)(F1 + i8 * 8 + 4);
                float kt[8];
#pragma unroll
                for (int e = 0; e < 4; ++e) { kt[e] = val[i8 * 8 + e] * f2a[e]; kt[e + 4] = val[i8 * 8 + 4 + e] * f2b[e]; val[i8 * 8 + e] *= f1a[e]; val[i8 * 8 + 4 + e] *= f1b[e]; }
                u32x4 w; w.x = pk2(kt[0], kt[1]); w.y = pk2(kt[2], kt[3]); w.z = pk2(kt[4], kt[5]); w.w = pk2(kt[6], kt[7]);
                *(u32x4*)(KT + i8 * 8) = w;
                asm volatile("" ::: "memory");
            }
        } else {
#pragma unroll
            for (int i8 = 0; i8 < 8; ++i8) {
#pragma unroll
                for (int e = 0; e < 8; ++e) val[i8 * 8 + e] *= BETA[i8 * 8 + e];
                asm volatile("" ::: "memory");
            }
        }
#pragma unroll
        for (int i8 = 0; i8 < 4; ++i8) {
            const f32x4 fa = *(const LAS f32x4*)(F3 + qt0 + i8 * 8), fb = *(const LAS f32x4*)(F3 + qt0 + i8 * 8 + 4);
#pragma unroll
            for (int e = 0; e < 4; ++e) {
                const int t = qt0 + i8 * 8 + e;
                QB[t * 136 + col] = f2bf(bf2f(QB[t * 136 + col]) * fa[e]); QB[(t + 4) * 136 + col] = f2bf(bf2f(QB[(t + 4) * 136 + col]) * fb[e]);
            }
            asm volatile("" ::: "memory");
        }
        bf16_t* ATT = (bf16_t*)(ws + OFF_PATT) + (size_t)uid * 4096;
#pragma unroll
        for (int k = 0; k < 2; ++k) { const int idx = tt + 256 * k, r = idx >> 3, c8 = (idx & 7) * 8; *(u32x4*)(ATT + r * 64 + c8) = *(const LAS u32x4*)(AT + r * 72 + c8); }
    }
#pragma unroll
    for (int i = 1; i < 64; ++i) {
        float a0 = 0.f, a1 = 0.f;
#pragma unroll
        for (int ch = 0; ch < (i + 3) / 4; ++ch) {
            const f32x4 l = *(const LAS f32x4*)(LF + i * 68 + ch * 4);
            a0 = __builtin_fmaf(l[0], val[4 * ch], a0); a1 = __builtin_fmaf(l[1], val[4 * ch + 1], a1);
            a0 = __builtin_fmaf(l[2], val[4 * ch + 2], a0); a1 = __builtin_fmaf(l[3], val[4 * ch + 3], a1);
        }
        val[i] -= (a0 + a1);
        asm volatile("" ::: "memory");
    }
    LDS_BARRIER();
    if (which) {
#pragma unroll
        for (int i = 0; i < 64; ++i) KB[i * 136 + col] = f2bf(val[i]);
    } else {
        bf16_t* UT = (bf16_t*)(ws + OFF_PUT) + (size_t)uid * 8192 + col * 64;
#pragma unroll
        for (int i8 = 0; i8 < 8; ++i8) { u32x4 w; w.x = pk2(val[i8 * 8], val[i8 * 8 + 1]); w.y = pk2(val[i8 * 8 + 2], val[i8 * 8 + 3]); w.z = pk2(val[i8 * 8 + 4], val[i8 * 8 + 5]); w.w = pk2(val[i8 * 8 + 6], val[i8 * 8 + 7]); *(u32x4*)(UT + i8 * 8) = w; }
    }
    LDS_BARRIER();
    {
        bf16_t* W = (bf16_t*)(ws + OFF_PW) + (size_t)uid * 8192;
        bf16_t* QD = (bf16_t*)(ws + OFF_PQD) + (size_t)uid * 8192;
#pragma unroll
        for (int k = 0; k < 4; ++k) { const int idx = tt + 256 * k, r = idx >> 4, c8 = (idx & 15) * 8;
            *(u32x4*)(W + r * 128 + c8) = *(const LAS u32x4*)(KB + r * 136 + c8);
            *(u32x4*)(QD + r * 128 + c8) = *(const LAS u32x4*)(QB + r * 136 + c8); }
    }
    LDS_BARRIER();
}

__device__ __forceinline__ void sg_unit(const Ctx& cx, LAS unsigned char* lds, const Params& p, int unit) {
    const int tid = cx.tid, lane = tid & 63, w = tid >> 6, fr = lane & 15, fq = lane >> 4;
    const int g = unit & 3, nb = (unit >> 2) & 63, b = unit >> 8;
    unsigned char* ws = cx.ws;
    GAS bf16_t* ZUV = (GAS bf16_t*)(ws + OFF_ZUV);
    LAS bf16_t* SVT = (LAS bf16_t*)lds;
    const size_t row0 = (size_t)b * SEQ + nb * 128;
    bf16x8 bw[4];
    { const GAS bf16_t* sgw = (const GAS bf16_t*)(ws + OFF_SGW) + (size_t)g * 16384 + (16 * w + fr) * 128 + fq * 8;
#pragma unroll
      for (int ks = 0; ks < 4; ++ks) bw[ks] = *(const GAS bf16x8*)(sgw + ks * 32); }
    {
        const int s = tid >> 2, qd = tid & 3;
        const GAS u32x4* src = (const GAS u32x4*)(ZUV + (row0 + s) * 1536 + 1024 + g * 128 + qd * 32);
        const GAS f32x4* gnp = (const GAS f32x4*)((const GAS float*)cx.in[13] + g * 128 + qd * 32);
        u32x4 xr[4]; f32x4 gn[8];
#pragma unroll
        for (int q = 0; q < 4; ++q) xr[q] = src[q];
#pragma unroll
        for (int q = 0; q < 8; ++q) gn[q] = gnp[q];
        float v[32]; float ss = 0.f;
#pragma unroll
        for (int q = 0; q < 4; ++q) {
#pragma unroll
            for (int e = 0; e < 4; ++e) { v[q * 8 + 2 * e] = bflo(xr[q][e]); v[q * 8 + 2 * e + 1] = bfhi(xr[q][e]); } }
#pragma unroll
        for (int e = 0; e < 32; ++e) ss += v[e] * v[e];
        ss += __shfl_xor(ss, 1); ss += __shfl_xor(ss, 2);
        const float r = rsqrtf(ss * (1.0f / 128.0f) + 1e-6f);
#pragma unroll
        for (int e = 0; e < 32; ++e) SVT[(qd * 32 + e) * 136 + s] = f2bf(v[e] * r * gn[e >> 2][e & 3]);
    }
    const int t = 16 * w + fr;
    GAS bf16_t* su = ZUV + (row0 + t) * 1536 + 512 + g * 128 + fq * 4;
    u32x2 sux[8];
#pragma unroll
    for (int nt = 0; nt < 8; ++nt) sux[nt] = *(const GAS u32x2*)(su + 16 * nt);
    const float bias = *((const GAS float*)cx.in[15] + g * 128 + t);
    __syncthreads();
    f32x4 acc[8];
#pragma unroll
    for (int nt = 0; nt < 8; ++nt) acc[nt] = (f32x4){0.f, 0.f, 0.f, 0.f};
#pragma unroll
    for (int ks = 0; ks < 4; ++ks) {
        if (ks * 32 <= 16 * w + 15) {
            bf16x8 a[8];
#pragma unroll
            for (int nt = 0; nt < 8; ++nt) a[nt] = *(const LAS bf16x8*)(SVT + (16 * nt + fr) * 136 + ks * 32 + fq * 8);
            asm volatile("" ::: "memory");
#pragma unroll
            for (int nt = 0; nt < 8; ++nt) acc[nt] = MFMA16(a[nt], bw[ks], acc[nt]);
        }
    }
#pragma unroll
    for (int nt = 0; nt < 8; ++nt) {
        const u32x2 x = sux[nt];
        u32x2 o; o.x = pk2(bflo(x.x) * (acc[nt][0] + bias), bfhi(x.x) * (acc[nt][1] + bias)); o.y = pk2(bflo(x.y) * (acc[nt][2] + bias), bfhi(x.y) * (acc[nt][3] + bias));
        *(GAS u32x2*)(su + 16 * nt) = o;
    }
    __syncthreads();
}

struct ScanStage { bf16x8 aw[4]; bf16x8 akt[2]; u32x2 uu; float eg; };
__device__ __forceinline__ void scan_load(ScanStage& st, const bf16_t* PW, const bf16_t* PUT, const bf16_t* PKT, const float* EG, int uid, int w, int mt, int fr, int fq, int dv0) {
    const size_t ub = (size_t)uid * 8192;
    if (w < 4) {
#pragma unroll
        for (int ks = 0; ks < 4; ++ks) st.aw[ks] = *(const GAS bf16x8*)(PW + ub + (16 * mt + fr) * 128 + ks * 32 + fq * 8);
        st.uu = *(const GAS u32x2*)(PUT + ub + (dv0 + fr) * 64 + 16 * mt + fq * 4);
    }
#pragma unroll
    for (int k2 = 0; k2 < 2; ++k2) st.akt[k2] = *(const GAS bf16x8*)(PKT + ub + (16 * w + fr) * 64 + k2 * 32 + fq * 8);
    st.eg = *(const GAS float*)(EG + uid);
}
__device__ __forceinline__ void scan_step(const ScanStage& st, f32x4& S, LAS bf16_t* ST, LAS bf16_t* VT, bf16_t* STT, bf16_t* VNT, int uid, bool last, int w, int mt, int fr, int fq, int dv0) {
    if (w < 4) {
        f32x4 T = {0.f, 0.f, 0.f, 0.f};
        bf16x8 bs[4];
#pragma unroll
        for (int ks = 0; ks < 4; ++ks) bs[ks] = *(const LAS bf16x8*)(ST + fr * 136 + ks * 32 + fq * 8);
        asm volatile("" ::: "memory");
        f32x4 T1 = {0.f, 0.f, 0.f, 0.f};
        T = MFMA16(st.aw[0], bs[0], T); T1 = MFMA16(st.aw[2], bs[2], T1);
        T = MFMA16(st.aw[1], bs[1], T); T1 = MFMA16(st.aw[3], bs[3], T1);
        T += T1;
        u32x2 o; o.x = pk2(bflo(st.uu.x) - T[0], bfhi(st.uu.x) - T[1]); o.y = pk2(bflo(st.uu.y) - T[2], bfhi(st.uu.y) - T[3]);
        *(LAS u32x2*)(VT + fr * 72 + 16 * mt + fq * 4) = o;
        *(GAS u32x2*)(VNT + (size_t)uid * 8192 + (dv0 + fr) * 64 + 16 * mt + fq * 4) = o;
    }
    LDS_BARRIER();
    {
        f32x4 acc = S * st.eg;
#pragma unroll
        for (int k2 = 0; k2 < 2; ++k2) { const bf16x8 bv = *(const LAS bf16x8*)(VT + fr * 72 + k2 * 32 + fq * 8); acc = MFMA16(st.akt[k2], bv, acc); }
        S = acc;
        u32x2 o; o.x = pk2(S[0], S[1]); o.y = pk2(S[2], S[3]);
        *(LAS u32x2*)(ST + fr * 136 + 16 * w + fq * 4) = o;
        if (!last) *(GAS u32x2*)(STT + (size_t)(uid + 1) * 16384 + (dv0 + fr) * 128 + 16 * w + fq * 4) = o;
    }
    LDS_BARRIER();
}
__device__ __forceinline__ void phase_scan(const Ctx& cx, LAS unsigned char* lds, const Params& p) {
    if (cx.bid >= 128) return;
    const int tid = cx.tid, lane = tid & 63, w = __builtin_amdgcn_readfirstlane(tid >> 6), fr = lane & 15, fq = lane >> 4;
    const int bh = (cx.bid & 7) + 8 * (cx.bid >> 6), dv0 = ((cx.bid >> 3) & 7) * 16;
    unsigned char* ws = cx.ws;
    LAS bf16_t* ST = (LAS bf16_t*)lds;
    LAS bf16_t* VT = (LAS bf16_t*)(lds + 4352);
    const bf16_t* PW = (const bf16_t*)(ws + OFF_PW); const bf16_t* PUT = (const bf16_t*)(ws + OFF_PUT); const bf16_t* PKT = (const bf16_t*)(ws + OFF_PKT);
    const float* EG = (const float*)(ws + OFF_EG);
    bf16_t* STT = (bf16_t*)(ws + OFF_STT); bf16_t* VNT = (bf16_t*)(ws + OFF_VNT);
    for (int i = tid; i < 16 * 136 / 2; i += NTHREADS) ((LAS unsigned*)ST)[i] = 0u;
    f32x4 S = {0.f, 0.f, 0.f, 0.f};
    const int uid0 = bh * 128;
    const int mt = w & 3;
    ScanStage s0, s1, s2, s3;
    scan_load(s0, PW, PUT, PKT, EG, uid0 + 0, w, mt, fr, fq, dv0);
    scan_load(s1, PW, PUT, PKT, EG, uid0 + 1, w, mt, fr, fq, dv0);
    scan_load(s2, PW, PUT, PKT, EG, uid0 + 2, w, mt, fr, fq, dv0);
    scan_load(s3, PW, PUT, PKT, EG, uid0 + 3, w, mt, fr, fq, dv0);
    __syncthreads();
#pragma unroll 1
    for (int n = 0; n < 128; n += 4) {
        scan_step(s0, S, ST, VT, STT, VNT, uid0 + n, false, w, mt, fr, fq, dv0);
        scan_load(s0, PW, PUT, PKT, EG, uid0 + min(n + 4, 127), w, mt, fr, fq, dv0);
        scan_step(s1, S, ST, VT, STT, VNT, uid0 + n + 1, false, w, mt, fr, fq, dv0);
        scan_load(s1, PW, PUT, PKT, EG, uid0 + min(n + 5, 127), w, mt, fr, fq, dv0);
        scan_step(s2, S, ST, VT, STT, VNT, uid0 + n + 2, false, w, mt, fr, fq, dv0);
        scan_load(s2, PW, PUT, PKT, EG, uid0 + min(n + 6, 127), w, mt, fr, fq, dv0);
        scan_step(s3, S, ST, VT, STT, VNT, uid0 + n + 3, n + 3 == 127, w, mt, fr, fq, dv0);
        scan_load(s3, PW, PUT, PKT, EG, uid0 + min(n + 7, 127), w, mt, fr, fq, dv0);
    }
}

__device__ __forceinline__ void out_unit(const Ctx& cx, const Params& p, int uid) {
    const int tid = cx.tid, lane = tid & 63, wl = (tid >> 6) & 3, fr = lane & 15, fq = lane >> 4;
    const int n = uid & 127, h = (uid >> 7) & 3, b = uid >> 9;
    unsigned char* ws = cx.ws;
    const GAS bf16_t* QD = (const GAS bf16_t*)(ws + OFF_PQD) + (size_t)uid * 8192 + (16 * wl + fr) * 128 + fq * 8;
    const GAS bf16_t* ATT = (const GAS bf16_t*)(ws + OFF_PATT) + (size_t)uid * 4096 + (16 * wl + fr) * 64 + fq * 8;
    const GAS bf16_t* STT = (const GAS bf16_t*)(ws + OFF_STT) + (size_t)uid * 16384 + fr * 128 + fq * 8;
    const GAS bf16_t* VNT = (const GAS bf16_t*)(ws + OFF_VNT) + (size_t)uid * 8192 + fr * 64 + fq * 8;
    const size_t row = (size_t)b * SEQ + n * 64 + 16 * wl + fr;
    GAS bf16_t* z = (GAS bf16_t*)(ws + OFF_ZUV) + row * 1536 + h * 128 + fq * 4;
    const bool hasS = n > 0;
    bf16x8 qd[4], at[2], fb[2][6];
#pragma unroll
    for (int ks = 0; ks < 4; ++ks) qd[ks] = *(const GAS bf16x8*)(QD + ks * 32);
#pragma unroll
    for (int k2 = 0; k2 < 2; ++k2) at[k2] = *(const GAS bf16x8*)(ATT + k2 * 32);
#pragma unroll
    for (int ks = 0; ks < 4; ++ks) fb[0][ks] = hasS ? *(const GAS bf16x8*)(STT + ks * 32) : (bf16x8){0, 0, 0, 0, 0, 0, 0, 0};
#pragma unroll
    for (int k2 = 0; k2 < 2; ++k2) fb[0][4 + k2] = *(const GAS bf16x8*)(VNT + k2 * 32);
    f32x4 acc[8];
    u32x2 zx[8];
    f32x4 gnv[8];
    { const GAS float* gn = (const GAS float*)cx.in[12] + fq * 4;
#pragma unroll
      for (int nt = 0; nt < 8; ++nt) gnv[nt] = *(const GAS f32x4*)(gn + 16 * nt); }
#pragma unroll
    for (int nt = 0; nt < 8; ++nt) {
        if (nt < 7) {
#pragma unroll
            for (int ks = 0; ks < 4; ++ks) fb[(nt + 1) & 1][ks] = hasS ? *(const GAS bf16x8*)(STT + (nt + 1) * 16 * 128 + ks * 32) : (bf16x8){0, 0, 0, 0, 0, 0, 0, 0};
#pragma unroll
            for (int k2 = 0; k2 < 2; ++k2) fb[(nt + 1) & 1][4 + k2] = *(const GAS bf16x8*)(VNT + (nt + 1) * 16 * 64 + k2 * 32);
        } else {
#pragma unroll
            for (int q = 0; q < 8; ++q) zx[q] = *(const GAS u32x2*)(z + 16 * q);
        }
        asm volatile("" ::: "memory");
        acc[nt] = (f32x4){0.f, 0.f, 0.f, 0.f};
        if (hasS) {
#pragma unroll
            for (int ks = 0; ks < 4; ++ks) acc[nt] = MFMA16(fb[nt & 1][ks], qd[ks], acc[nt]);
        }
#pragma unroll
        for (int k2 = 0; k2 < 2; ++k2) acc[nt] = MFMA16(fb[nt & 1][4 + k2], at[k2], acc[nt]);
    }
    float ss = 0.f;
#pragma unroll
    for (int nt = 0; nt < 8; ++nt) ss += (acc[nt][0] * acc[nt][0] + acc[nt][1] * acc[nt][1]) + (acc[nt][2] * acc[nt][2] + acc[nt][3] * acc[nt][3]);
    ss += __shfl_xor(ss, 16); ss += __shfl_xor(ss, 32);
    const float rr = rsqrtf(ss * (1.0f / 128.0f) + 1e-6f);
#pragma unroll
    for (int nt = 0; nt < 8; ++nt) {
        const u32x2 x = zx[nt];
        const f32x4 gv = gnv[nt];
        u32x2 o; o.x = pk2(acc[nt][0] * rr * gv[0] * bflo(x.x), acc[nt][1] * rr * gv[1] * bfhi(x.x)); o.y = pk2(acc[nt][2] * rr * gv[2] * bflo(x.y), acc[nt][3] * rr * gv[3] * bfhi(x.y));
        *(GAS u32x2*)(z + 16 * nt) = o;
    }
}

template <int WIN>
__device__ __forceinline__ void pool_body(const GAS bf16_t* xc, const LAS float* RS, float g0, float g1, GAS bf16_t* po, int tb) {
    unsigned xv[64 + WIN - 1];
#pragma unroll
    for (int i = 0; i < 64 + WIN - 1; ++i) { const int t = tb - (WIN - 1) + i; xv[i] = 0u; if (t >= 0) xv[i] = *(const GAS unsigned*)(xc + (long)(i - (WIN - 1)) * DM); }
    float s0 = 0.f, s1 = 0.f;
#pragma unroll
    for (int i = 0; i < WIN - 1; ++i) { const float r = RS[i + 16 - WIN]; s0 += bflo(xv[i]) * r; s1 += bfhi(xv[i]) * r; }
#pragma unroll
    for (int k = 0; k < 64; ++k) {
        const float r = RS[k + 15];
        const float h0 = bflo(xv[k + WIN - 1]) * r, h1 = bfhi(xv[k + WIN - 1]) * r;
        s0 += h0; s1 += h1;
        const int cnt = min(tb + k + 1, WIN);
        const float inv = __builtin_amdgcn_rcpf((float)cnt);
        *(GAS unsigned*)(po + (long)k * 256) = pk2((s0 * inv - h0) * g0, (s1 * inv - h1) * g1);
        const float rl = RS[k + 16 - WIN];
        s0 -= bflo(xv[k]) * rl; s1 -= bfhi(xv[k]) * rl;
    }
}
__device__ __forceinline__ void pool_unit(const Ctx& cx, LAS unsigned char* lds, const Params& p, const bf16_t* X, const float* ssq, int unit) {
    const int tid = cx.tid;
    const int tb = (unit & 127) * 64, b = unit >> 7;
    LAS float* RS = (LAS float*)lds;
    const size_t rowbase = (size_t)b * SEQ;
    if (tid < 79) { const int t = tb - 15 + tid; RS[tid] = (t >= 0) ? rstd_of(ssq, rowbase + t) : 0.f; }
    __syncthreads();
    const int c = tid * 2, g = tid >> 7;
    const float g0 = cx.in[4][DM + c], g1 = cx.in[4][DM + c + 1];
    const GAS bf16_t* xc = (const GAS bf16_t*)X + (rowbase + tb) * DM + c;
    GAS bf16_t* po = (GAS bf16_t*)(cx.ws + OFF_PO) + (size_t)g * MTOK * 256 + (rowbase + tb) * 256 + (c & 255);
    if (g == 0) pool_body<2>(xc, RS, g0, g1, po, tb);
    else if (g == 1) pool_body<4>(xc, RS, g0, g1, po, tb);
    else if (g == 2) pool_body<8>(xc, RS, g0, g1, po, tb);
    else pool_body<16>(xc, RS, g0, g1, po, tb);
    __syncthreads();
}

__device__ __forceinline__ void phase_final(const Ctx& cx, const Params& p, const bf16_t* XB, float* out) {
    const int wave = cx.tid >> 6, lane = cx.tid & 63;
    const float* gw = cx.in[19];
    f32x4 gg[4];
#pragma unroll
    for (int h2 = 0; h2 < 2; ++h2) { gg[2 * h2] = *(const GAS f32x4*)(gw + lane * 8 + h2 * 512); gg[2 * h2 + 1] = *(const GAS f32x4*)(gw + lane * 8 + h2 * 512 + 4); }
    for (int row = (cx.bid * 8 + wave) * 2; row < MTOK; row += cx.G * 16) {
        const GAS bf16_t* xr = (const GAS bf16_t*)XB + (size_t)row * DM + lane * 8;
        u32x4 x[4];
#pragma unroll
        for (int q = 0; q < 4; ++q) x[q] = *(const GAS u32x4*)(xr + (q >> 1) * DM + (q & 1) * 512);
        float v[4][8]; float ss[2] = {0.f, 0.f};
#pragma unroll
        for (int q = 0; q < 4; ++q) {
#pragma unroll
            for (int e = 0; e < 4; ++e) { v[q][2 * e] = bflo(x[q][e]); v[q][2 * e + 1] = bfhi(x[q][e]); }
#pragma unroll
            for (int e = 0; e < 8; ++e) ss[q >> 1] += v[q][e] * v[q][e];
        }
#pragma unroll
        for (int o = 1; o < 64; o <<= 1) { ss[0] += __shfl_xor(ss[0], o); ss[1] += __shfl_xor(ss[1], o); }
        const float r0 = rsqrtf(ss[0] * (1.0f / 1024.0f) + 1e-6f), r1 = rsqrtf(ss[1] * (1.0f / 1024.0f) + 1e-6f);
#pragma unroll
        for (int q = 0; q < 4; ++q) {
            const float r = (q >> 1) ? r1 : r0;
            const f32x4 g0 = gg[2 * (q & 1)], g1 = gg[2 * (q & 1) + 1];
            GAS float* o = (GAS float*)out + (size_t)(row + (q >> 1)) * DM + lane * 8 + (q & 1) * 512;
            *(GAS f32x4*)o = (f32x4){v[q][0] * r * g0[0], v[q][1] * r * g0[1], v[q][2] * r * g0[2], v[q][3] * r * g0[3]};
            *(GAS f32x4*)(o + 4) = (f32x4){v[q][4] * r * g1[0], v[q][5] * r * g1[1], v[q][6] * r * g1[2], v[q][7] * r * g1[3]};
        }
    }
}

enum { K_PROLOGUE = 0, K_SWIGLU, K_RESID, K_PROJ, K_PREP, K_SCAN, K_OUT, K_POOL, K_FINAL };

__global__ void __launch_bounds__(NTHREADS, 2) fwd_megakernel(Params p) {
    extern __shared__ __attribute__((aligned(16))) unsigned char lds_raw[];
    LAS unsigned char* lds = (LAS unsigned char*)lds_raw;
    cg::grid_group grid = cg::this_grid();
    volatile LAS unsigned* xbst = (volatile LAS unsigned*)(lds + 146432);
    if (threadIdx.x == 0) { xbst[0] = 0u; xbst[1] = 0u; }
    __syncthreads();
    {
        unsigned* bw = (unsigned*)(p.ws + OFF_BAR);
        if (blockIdx.x == 0) {
            for (int i = threadIdx.x; i < 4096; i += NTHREADS) if (i != XB_READY) bw[i] = 0u;
            asm volatile("s_waitcnt vmcnt(0)" ::: "memory");
            __syncthreads();
            if (threadIdx.x == 0) { __builtin_amdgcn_fence(__ATOMIC_RELEASE, "agent"); asm volatile("s_waitcnt vmcnt(0)" ::: "memory"); __hip_atomic_store(&bw[XB_READY], XB_MAGIC, __ATOMIC_RELAXED, __HIP_MEMORY_SCOPE_AGENT); }
        }
        if (threadIdx.x == 0) {
            unsigned sp = 0u;
            while (xb_ld(&bw[XB_READY]) != XB_MAGIC) { __builtin_amdgcn_s_sleep(1); if (++sp > (1u << 20)) break; }
            __builtin_amdgcn_fence(__ATOMIC_ACQUIRE, "agent");
            asm volatile("s_waitcnt vmcnt(0)" ::: "memory");
        }
        __syncthreads();
    }
    if (gridDim.x == 0x7fffffffu) grid.sync();
    const XcdBarrier xbar = xcd_barrier_post((unsigned*)(p.ws + OFF_BAR), xbst);
    { Ctx cx; cx.tid = threadIdx.x; cx.bid = blockIdx.x; cx.G = gridDim.x; cx.ws = p.ws; cx.in = nullptr;
#ifndef NO_PRO
      phase_prologue(cx, lds, p);
#endif
      xcd_barrier(xbar);
      if (blockIdx.x == 0 && threadIdx.x == 0) __hip_atomic_store((unsigned*)(p.ws + OFF_BAR) + XB_READY, 0u, __ATOMIC_RELAXED, __HIP_MEMORY_SCOPE_AGENT); }
#pragma unroll 1
    for (int step = 1; step < 17; ++step) {
        Ctx cx; cx.tid = threadIdx.x; cx.bid = blockIdx.x; cx.G = gridDim.x; cx.ws = p.ws;
        asm volatile("" : "+v"(cx.tid)); asm volatile("" : "+s"(cx.bid)); asm volatile("" : "+s"(cx.G)); asm volatile("" : "+s"(cx.ws));
        cx.in = (const float* const*)(cx.ws + OFF_TAB);
        unsigned char* ws = cx.ws; const int G = cx.G;
        float* X = p.out;
        bf16_t* XB = (bf16_t*)(ws + OFF_XB);
        float* SSQ0 = (float*)(ws + OFF_SSQ); float* SSQ1 = (float*)(ws + OFF_SSQ + SZ_SSQ1);
        int kind = K_PROLOGUE, widx = 0, sidx = 0;
        int rmode = 0;
        switch (step) {
            case 1: kind = K_SWIGLU; widx = 0; sidx = 0; break;
            case 2: kind = K_RESID; widx = 0; sidx = 0; rmode = 0; break;
            case 3: kind = K_PROJ; sidx = 1; break;
            case 4: kind = K_PREP; break;
            case 5: kind = K_SCAN; break;
            case 6: kind = K_OUT; break;
            case 7: kind = K_RESID; sidx = 1; rmode = 1; break;
            case 8: kind = K_SWIGLU; widx = 1; sidx = 0; break;
            case 9: kind = K_RESID; widx = 1; sidx = 0; rmode = 0; break;
            case 10: kind = K_SWIGLU; widx = 2; sidx = 1; break;
            case 11: kind = K_RESID; widx = 2; sidx = 1; rmode = 0; break;
            case 12: kind = K_POOL; sidx = 0; break;
            case 13: kind = K_RESID; sidx = 0; rmode = 2; break;
            case 14: kind = K_SWIGLU; widx = 3; sidx = 1; break;
            case 15: kind = K_RESID; widx = 3; sidx = 1; rmode = 0; break;
            default: kind = K_FINAL; break;
        }
        const float* ssq_in = sidx ? SSQ1 : SSQ0; float* ssq_out = sidx ? SSQ0 : SSQ1;
        if (kind == K_SWIGLU) {
            pg8::Gemm g{XB, (const bf16_t*)(ws + OFF_WFFIN + (size_t)widx * SZ_WFFIN1), MTOK, NFF, DM, DM, 0};
            pg8::StaticOrder S; S.init(MTOK, NFF, G, cx.bid);
            LAS float* RS = (LAS float*)(lds + 131072);
            { pg8::Unit uu; for (int i = 0; i < 15 && S.next(i, uu); ++i) { if (cx.tid < 256) RS[i * 256 + cx.tid] = rstd_of(ssq_in, (size_t)uu.pm * 256 + cx.tid); } __syncthreads(); }
            EpiSwiglu E{(bf16_t*)(ws + OFF_HB), RS, 0};
#ifndef NO_G1
            pg8::gemm_phase<EpiSwiglu, pg8::StaticOrder>(cx.tid, lds, g, S, E);
#endif
        } else if (kind == K_RESID) {
            const float* cs18 = cx.in[18];
            const bf16_t* gA = (const bf16_t*)(ws + (rmode == 0 ? OFF_HB : (rmode == 1 ? OFF_ZUV : OFF_PO)));
            const bf16_t* gB = (const bf16_t*)(ws + (rmode == 0 ? OFF_WFFOUT + (size_t)widx * SZ_WFFOUT1 : (rmode == 1 ? OFF_WABOUT : OFF_WPOOL)));
            const int gK = rmode == 0 ? FF : (rmode == 1 ? DM : 256), glda = rmode == 0 ? FF : (rmode == 1 ? 1536 : 256);
            const size_t gapn = rmode == 2 ? (size_t)MTOK * 256 * 2 : 0;
            const float* cscale = rmode == 2 ? cs18 : (const float*)(ws + OFF_SCL) + (rmode == 1 ? 1024 : 0);
            pg8::Gemm g{gA, gB, MTOK, DM, gK, glda, gapn};
            EpiResid E{XB, ssq_out, cscale};
            pg8::StaticOrder S; S.init(MTOK, DM, G, cx.bid);
#ifndef NO_G2
            pg8::gemm_phase<EpiResid, pg8::StaticOrder>(cx.tid, lds, g, S, E);
#endif
        } else if (kind == K_PROJ) {
            pg8::Gemm g{XB, (const bf16_t*)(ws + OFF_WABIN), MTOK, NPROJ, DM, DM, 0};
            pg8::StaticOrder S; S.init(MTOK, NPROJ, G, cx.bid);
            LAS float* RS = (LAS float*)(lds + 131072);
            { pg8::Unit uu; for (int i = 0; i < 15 && S.next(i, uu); ++i) { if (cx.tid < 256) RS[i * 256 + cx.tid] = rstd_of(ssq_in, (size_t)uu.pm * 256 + cx.tid); } __syncthreads(); }
            EpiProj E{(bf16_t*)(ws + OFF_QKV), (bf16_t*)(ws + OFF_ZUV), (float*)(ws + OFF_BA), RS, 0};
#ifndef NO_G3
            pg8::gemm_phase<EpiProj, pg8::StaticOrder>(cx.tid, lds, g, S, E);
#endif
        } else if (kind == K_PREP) {
#pragma unroll 1
#ifndef NO_PREP
            for (int u = cx.bid; u < 1024; u += G) prep_unit(cx, lds, p, u);
#else
            for (int u = cx.bid; u < 0; u += G) {}
#endif
        } else if (kind == K_SCAN) {
#ifndef NO_SCAN
            if (cx.bid >= 128) {
                convert_tiles<false>(cx, lds, p, CT_EARLY, CT_ALL, cx.bid - 128, G - 128);
#pragma unroll 1
                for (int u = cx.bid - 128; u < 1024; u += G - 128) sg_unit(cx, lds, p, u);
            }
            phase_scan(cx, lds, p);
#endif
        } else if (kind == K_OUT) {
#pragma unroll 1
#ifndef NO_OUT
            for (int u = cx.bid; u < 1024; u += G) out_unit(cx, p, 2 * u + (cx.tid >> 8));
#else
            for (int u = cx.bid; u < 0; u += G) {}
#endif
        } else if (kind == K_POOL) {
#pragma unroll 1
#ifndef NO_POOL
            for (int u = cx.bid; u < 512; u += G) pool_unit(cx, lds, p, XB, ssq_in, u);
#else
            for (int u = cx.bid; u < 0; u += G) {}
#endif
        } else {
#ifndef NO_FIN
            phase_final(cx, p, XB, X);
#endif
        }
        if (step < 16) xcd_barrier(xbar);
    }
}

extern "C" void kernel_launch(void* const* d_in, const int* in_sizes, int n_in, void* d_out, int out_size, void* d_ws, size_t ws_size, hipStream_t stream) {
    static int grid_blocks = 0;
    if (grid_blocks == 0) {
        if (n_in != 20 || ws_size < WS_END) { fprintf(stderr, "kernel_launch: need 20 inputs and %zu bytes of workspace (got %d, %zu)\n", (size_t)WS_END, n_in, ws_size); grid_blocks = -1; return; }
        int dev = 0, cus = 0, per_cu = 0;
        (void)hipGetDevice(&dev);
        (void)hipDeviceGetAttribute(&cus, hipDeviceAttributeMultiprocessorCount, dev);
        if (hipFuncSetAttribute((const void*)fwd_megakernel, hipFuncAttributeMaxDynamicSharedMemorySize, LDS_BYTES) != hipSuccess) { fprintf(stderr, "kernel_launch: hipFuncSetAttribute failed\n"); grid_blocks = -1; return; }
        if (hipOccupancyMaxActiveBlocksPerMultiprocessor(&per_cu, (const void*)fwd_megakernel, NTHREADS, LDS_BYTES) != hipSuccess || per_cu < 1) per_cu = 1;
        (void)hipGetLastError();
        grid_blocks = cus * 1;
        if (grid_blocks < 128) { fprintf(stderr, "kernel_launch: needs >= 128 CUs\n"); grid_blocks = -1; return; }
    }
    if (grid_blocks < 0) return;
    Params p{};
    for (int i = 0; i < 20; ++i) p.in[i] = (const float*)d_in[i];
    p.out = (float*)d_out; p.ws = (unsigned char*)d_ws;
    void* args[] = {&p};
    hipError_t e = hipLaunchCooperativeKernel((const void*)fwd_megakernel, dim3(grid_blocks), dim3(NTHREADS), args, LDS_BYTES, stream);
    if (e != hipSuccess) fprintf(stderr, "cooperative launch failed: %s (grid %d)\n", hipGetErrorString(e), grid_blocks);
}
```
